# Optimizing an MI355X kernel written in HIP

```python
import math
import jax, jax.numpy as jnp
from jax import lax
import numpy as np

D_MODEL = 1024
BATCH = 8
SEQ = 8192
DEPTH = 2

D_MIX = D_MODEL
S5_WIDTH = D_MIX // 4
S5_GROUP = 16
S5_GROUPS = S5_WIDTH // S5_GROUP
S5_STATE = 64
S5_MIN_DECAY = 1e-4
GLA_WIDTH = D_MIX // 2
GLA_HEADS = 4
GLA_DV = GLA_WIDTH // GLA_HEADS
GLA_DK = GLA_DV // 2
GLA_KEY_WIDTH = GLA_HEADS * GLA_DK
GLA_GATE_RANK = 16
GLA_TAU = 16.0
GLA_CHUNK = 64
LRU_WIDTH = D_MIX - S5_WIDTH - GLA_WIDTH
LRU_BLOCKS = 8
LRU_BLOCK = LRU_WIDTH // LRU_BLOCKS
LRU_CONV = 4
LRU_C = 8.0
D_FF = 4 * D_MODEL
DEEPNORM_ALPHA = (2 * DEPTH) ** 0.25
DEEPNORM_BETA = (8 * DEPTH) ** -0.25
LN_EPS = 1e-5
RMS_EPS = 1e-6
SPLIT_SIZES = (S5_WIDTH, GLA_KEY_WIDTH, GLA_KEY_WIDTH, GLA_WIDTH, GLA_WIDTH,
               GLA_GATE_RANK, LRU_WIDTH, LRU_WIDTH)
D_IN = sum(SPLIT_SIZES)

kernel_name = 'hymba_style_s5_gla_rglru_deepnorm'


def _layer_norm(x, g, b):
    xf = x.astype(jnp.float32)
    mu = jnp.mean(xf, axis=-1, keepdims=True)
    var = jnp.mean(jnp.square(xf - mu), axis=-1, keepdims=True)
    return ((xf - mu) * lax.rsqrt(var + LN_EPS) * g + b).astype(x.dtype)


def _complex_affine_combine(e1, e2):
    ar1, ai1, br1, bi1 = e1
    ar2, ai2, br2, bi2 = e2
    ar = ar2 * ar1 - ai2 * ai1
    ai = ar2 * ai1 + ai2 * ar1
    br = ar2 * br1 - ai2 * bi1 + br2
    bi = ar2 * bi1 + ai2 * br1 + bi2
    return (ar, ai, br, bi)


def _real_affine_combine(e1, e2):
    a1, b1 = e1
    a2, b2 = e2
    return (a2 * a1, a2 * b1 + b2)


def _s5_mixer(u, lam_re, lam_im, log_dt, b_re, b_im, c_re, c_im, d_skip, w_glu):
    bsz, seq, _ = u.shape
    f32 = jnp.float32
    u = u.astype(f32)
    ug = u.reshape(bsz, seq, S5_GROUPS, S5_GROUP)
    dt = jnp.exp(log_dt.astype(f32))[:, None]
    lr = jnp.minimum(lam_re.astype(f32), -S5_MIN_DECAY)
    li = lam_im.astype(f32)
    mag = jnp.exp(lr * dt)
    a_re = mag * jnp.cos(li * dt)
    a_im = mag * jnp.sin(li * dt)
    den = lr * lr + li * li
    f_re = ((a_re - 1.0) * lr + a_im * li) / den
    f_im = (a_im * lr - (a_re - 1.0) * li) / den
    bb_re = f_re[..., None] * b_re - f_im[..., None] * b_im
    bb_im = f_re[..., None] * b_im + f_im[..., None] * b_re
    bu_re = jnp.einsum('blgc,gpc->blgp', ug, bb_re)
    bu_im = jnp.einsum('blgc,gpc->blgp', ug, bb_im)
    shape_a = (1, seq, S5_GROUPS, S5_STATE)
    a_re_t = jnp.broadcast_to(a_re, shape_a)
    a_im_t = jnp.broadcast_to(a_im, shape_a)
    _, _, h_re, h_im = lax.associative_scan(
        _complex_affine_combine, (a_re_t, a_im_t, bu_re, bu_im), axis=1)
    y = (jnp.einsum('blgp,gcp->blgc', h_re, c_re)
         - jnp.einsum('blgp,gcp->blgc', h_im, c_im))
    y = y.reshape(bsz, seq, S5_WIDTH) + d_skip * u
    y = jax.nn.gelu(y)
    return y * jax.nn.sigmoid(y @ w_glu)


def _gla_mixer(q, k, v, r, gz, w_gate_up, b_gate, norm_g):
    bsz, seq, _ = q.shape
    f32 = jnp.float32
    n_chunks = seq // GLA_CHUNK
    q, k, v, r, gz = (t.astype(f32) for t in (q, k, v, r, gz))
    g = jax.nn.log_sigmoid(gz @ w_gate_up + b_gate) / GLA_TAU

    def chunks(t, d):
        return t.reshape(bsz, n_chunks, GLA_CHUNK, GLA_HEADS, d).transpose(0, 3, 1, 2, 4)

    qc = chunks(q, GLA_DK) * (GLA_DK ** -0.5)
    kc = chunks(k, GLA_DK)
    gc = chunks(g, GLA_DK)
    vc = chunks(v, GLA_DV)
    bcum = jnp.cumsum(gc, axis=3)
    blast = bcum[:, :, :, -1:, :]
    qe = qc * jnp.exp(bcum)
    ke = kc * jnp.exp(-bcum)
    mask = jnp.tril(jnp.ones((GLA_CHUNK, GLA_CHUNK), dtype=bool))
    scores = jnp.where(mask, jnp.einsum('bhnid,bhnjd->bhnij', qe, ke), 0.0)
    o_intra = jnp.einsum('bhnij,bhnje->bhnie', scores, vc)
    kd = kc * jnp.exp(blast - bcum)
    upd = jnp.einsum('bhncd,bhnce->nbhde', kd, vc)
    decay = jnp.exp(blast[:, :, :, 0, :]).transpose(2, 0, 1, 3)

    def step(state, inp):
        dec, u = inp
        return dec[..., None] * state + u, state

    s0 = jnp.zeros((bsz, GLA_HEADS, GLA_DK, GLA_DV), f32)
    _, s_prev = lax.scan(step, s0, (decay, upd))
    o_inter = jnp.einsum('bhncd,nbhde->bhnce', qe, s_prev)
    o = (o_intra + o_inter).transpose(0, 2, 3, 1, 4).reshape(bsz, seq, GLA_HEADS, GLA_DV)
    o = o * lax.rsqrt(jnp.mean(jnp.square(o), axis=-1, keepdims=True) + RMS_EPS) * norm_g
    return o.reshape(bsz, seq, GLA_WIDTH) * jax.nn.silu(r)


def _rglru_mixer(xb, gb, conv_w, conv_b, w_r, b_r, w_i, b_i, lam):
    bsz, seq, _ = xb.shape
    f32 = jnp.float32
    xb = xb.astype(f32)
    gb = gb.astype(f32)
    xc = lax.conv_general_dilated(
        xb, conv_w.astype(f32)[:, None, :], window_strides=(1,),
        padding=((LRU_CONV - 1, 0),), dimension_numbers=('NWC', 'WIO', 'NWC'),
        feature_group_count=LRU_WIDTH) + conv_b
    xblk = xc.reshape(bsz, seq, LRU_BLOCKS, LRU_BLOCK)
    gate_r = jax.nn.sigmoid(
        jnp.einsum('blhi,hij->blhj', xblk, w_r).reshape(bsz, seq, LRU_WIDTH) + b_r)
    gate_i = jax.nn.sigmoid(
        jnp.einsum('blhi,hij->blhj', xblk, w_i).reshape(bsz, seq, LRU_WIDTH) + b_i)
    log_a = -LRU_C * gate_r * jax.nn.softplus(-lam)
    a = jnp.exp(log_a)
    bterm = jnp.sqrt(-jnp.expm1(2.0 * log_a)) * (gate_i * xc)
    _, h = lax.associative_scan(_real_affine_combine, (a, bterm), axis=1)
    return h * jax.nn.gelu(gb)


def setup_inputs(seed: int = 0) -> dict:
    key = jax.random.key(seed)
    ks = jax.random.split(key, 32)
    f32 = jnp.float32
    L = DEPTH

    def nrm(k, shape, scale):
        return scale * jax.random.normal(k, shape, f32)

    x = jax.random.normal(ks[0], (BATCH, SEQ, D_MODEL), f32)
    ln_in_g = 1.0 + nrm(ks[1], (D_MODEL,), 0.02)
    ln_in_b = nrm(ks[2], (D_MODEL,), 0.02)
    w_in = nrm(ks[3], (L, D_MODEL, D_IN), D_MODEL ** -0.5)
    s5_lambda_re = -0.5 + nrm(ks[4], (L, S5_GROUPS, S5_STATE), 0.01)
    s5_lambda_im = (jnp.pi * jnp.arange(S5_STATE, dtype=f32)[None, None, :]
                    + nrm(ks[5], (L, S5_GROUPS, S5_STATE), 0.01))
    s5_log_dt = jax.random.uniform(ks[6], (L, S5_GROUPS), f32,
                                   minval=math.log(1e-3), maxval=math.log(1e-1))
    s5_b_re = nrm(ks[7], (L, S5_GROUPS, S5_STATE, S5_GROUP), (2 * S5_GROUP) ** -0.5)
    s5_b_im = nrm(ks[8], (L, S5_GROUPS, S5_STATE, S5_GROUP), (2 * S5_GROUP) ** -0.5)
    s5_c_re = nrm(ks[9], (L, S5_GROUPS, S5_GROUP, S5_STATE), (2 * S5_STATE) ** -0.5)
    s5_c_im = nrm(ks[10], (L, S5_GROUPS, S5_GROUP, S5_STATE), (2 * S5_STATE) ** -0.5)
    s5_d = nrm(ks[11], (L, S5_WIDTH), 1.0)
    s5_w_glu = nrm(ks[12], (L, S5_WIDTH, S5_WIDTH), S5_WIDTH ** -0.5)
    gla_w_gate_up = nrm(ks[13], (L, GLA_GATE_RANK, GLA_KEY_WIDTH), GLA_GATE_RANK ** -0.5)
    gla_b_gate = nrm(ks[14], (L, GLA_KEY_WIDTH), 0.02)
    gla_norm_g = 1.0 + nrm(ks[15], (L, GLA_DV), 0.02)
    lru_conv_w = nrm(ks[16], (L, LRU_CONV, LRU_WIDTH), LRU_CONV ** -0.5)
    lru_conv_b = nrm(ks[17], (L, LRU_WIDTH), 0.02)
    lru_w_r = nrm(ks[18], (L, LRU_BLOCKS, LRU_BLOCK, LRU_BLOCK), LRU_BLOCK ** -0.5)
    lru_b_r = nrm(ks[19], (L, LRU_WIDTH), 0.02)
    lru_w_i = nrm(ks[20], (L, LRU_BLOCKS, LRU_BLOCK, LRU_BLOCK), LRU_BLOCK ** -0.5)
    lru_b_i = nrm(ks[21], (L, LRU_WIDTH), 0.02)
    u = jax.random.uniform(ks[22], (L, LRU_WIDTH), f32, minval=0.9, maxval=0.999)
    p = u ** (1.0 / LRU_C)
    lru_lambda = jnp.log(p) - jnp.log1p(-p)
    w_out = nrm(ks[23], (L, D_MIX, D_MODEL), DEEPNORM_BETA * D_MIX ** -0.5)
    ln1_g = 1.0 + nrm(ks[24], (L, D_MODEL), 0.02)
    ln1_b = nrm(ks[25], (L, D_MODEL), 0.02)
    mlp_w1 = nrm(ks[26], (L, D_MODEL, D_FF), D_MODEL ** -0.5)
    mlp_w2 = nrm(ks[27], (L, D_FF, D_MODEL), DEEPNORM_BETA * D_FF ** -0.5)
    ln2_g = 1.0 + nrm(ks[28], (L, D_MODEL), 0.02)
    ln2_b = nrm(ks[29], (L, D_MODEL), 0.02)
    return {
        'x': x, 'ln_in_g': ln_in_g, 'ln_in_b': ln_in_b, 'w_in': w_in,
        's5_lambda_re': s5_lambda_re, 's5_lambda_im': s5_lambda_im, 's5_log_dt': s5_log_dt,
        's5_b_re': s5_b_re, 's5_b_im': s5_b_im, 's5_c_re': s5_c_re, 's5_c_im': s5_c_im,
        's5_d': s5_d, 's5_w_glu': s5_w_glu,
        'gla_w_gate_up': gla_w_gate_up, 'gla_b_gate': gla_b_gate, 'gla_norm_g': gla_norm_g,
        'lru_conv_w': lru_conv_w, 'lru_conv_b': lru_conv_b, 'lru_w_r': lru_w_r,
        'lru_b_r': lru_b_r, 'lru_w_i': lru_w_i, 'lru_b_i': lru_b_i, 'lru_lambda': lru_lambda,
        'w_out': w_out, 'ln1_g': ln1_g, 'ln1_b': ln1_b,
        'mlp_w1': mlp_w1, 'mlp_w2': mlp_w2, 'ln2_g': ln2_g, 'ln2_b': ln2_b,
    }


def reference(x, ln_in_g, ln_in_b, w_in, s5_lambda_re, s5_lambda_im, s5_log_dt,
              s5_b_re, s5_b_im, s5_c_re, s5_c_im, s5_d, s5_w_glu,
              gla_w_gate_up, gla_b_gate, gla_norm_g,
              lru_conv_w, lru_conv_b, lru_w_r, lru_b_r, lru_w_i, lru_b_i, lru_lambda,
              w_out, ln1_g, ln1_b, mlp_w1, mlp_w2, ln2_g, ln2_b):
    split_points = tuple(int(s) for s in np.cumsum(SPLIT_SIZES)[:-1])
    h = _layer_norm(x, ln_in_g, ln_in_b)
    for l in range(DEPTH):
        z = h @ w_in[l]
        s5_u, g_q, g_k, g_v, g_r, g_z, lru_x, lru_g = jnp.split(z, split_points, axis=-1)
        y_s5 = _s5_mixer(s5_u, s5_lambda_re[l], s5_lambda_im[l], s5_log_dt[l],
                         s5_b_re[l], s5_b_im[l], s5_c_re[l], s5_c_im[l], s5_d[l], s5_w_glu[l])
        y_gla = _gla_mixer(g_q, g_k, g_v, g_r, g_z, gla_w_gate_up[l], gla_b_gate[l],
                           gla_norm_g[l])
        y_lru = _rglru_mixer(lru_x, lru_g, lru_conv_w[l], lru_conv_b[l], lru_w_r[l],
                             lru_b_r[l], lru_w_i[l], lru_b_i[l], lru_lambda[l])
        mix = jnp.concatenate([y_s5, y_gla, y_lru], axis=-1) @ w_out[l]
        h = _layer_norm(DEEPNORM_ALPHA * h + mix, ln1_g[l], ln1_b[l])
        ff = jnp.square(jax.nn.relu(h @ mlp_w1[l])) @ mlp_w2[l]
        h = _layer_norm(DEEPNORM_ALPHA * h + ff, ln2_g[l], ln2_b[l])
    return h
```

```cpp
#include <hip/hip_runtime.h>
#include <hip/hip_cooperative_groups.h>
#include <cstdio>
#include <cstdint>
namespace cg = cooperative_groups;
#ifndef REP_GEMM
#define REP_GEMM 0
#endif
#ifndef REP_GLA
#define REP_GLA 0
#endif
#ifndef REP_S5
#define REP_S5 0
#endif
#ifndef REP_MIX
#define REP_MIX 0
#endif

#define LAS __attribute__((address_space(3)))
typedef unsigned short bf16_t;
typedef short bf16x8 __attribute__((ext_vector_type(8)));
typedef float f32x4 __attribute__((ext_vector_type(4)));
typedef float f32x2 __attribute__((ext_vector_type(2)));
typedef unsigned u32x4 __attribute__((ext_vector_type(4)));
typedef unsigned u32x2 __attribute__((ext_vector_type(2)));

namespace pg8 {
constexpr int BM = 256, BK = 64, HALF = 128, HTB = HALF * BK * 2, STAGE_BYTES = 8 * HTB;
__host__ __device__ __forceinline__ int lds_byte(int r, int c) { const int st = (r >> 4) * 2 + (c >> 5), rr = r & 15, cc = c & 31, ob = rr * 64 + cc * 2; return st * 1024 + (ob ^ (((ob >> 9) & 1) << 5)); }
__host__ __device__ __forceinline__ void stage_rc(int b, int& R, int& C) { const int st = b / 1024, sb = b % 1024, swz = sb ^ (((sb >> 9) & 1) << 5); R = (st >> 1) * 16 + swz / 64; C = (st & 1) * 32 + (swz % 64) / 2; }
__host__ __device__ __forceinline__ int perm32(int rho) { const int n = rho >> 4, i = rho & 15; return 8 * (i >> 2) + 4 * n + (i & 3); }
struct Unit { int pm, pn; };
struct Gemm { const bf16_t* A; const bf16_t* Bt; int K; };
struct PanelOrder {
    int nN;
    __device__ __forceinline__ bool next(int i, Unit& u) const { u.pm = 0; u.pn = i; return i < nN; }
    __device__ __forceinline__ void a_ready(const Unit&) const {}
    __device__ __forceinline__ void done(const Unit&) const {}
};
__device__ __forceinline__ float bflo_(unsigned w) { return __uint_as_float(w << 16); }
__device__ __forceinline__ float bfhi_(unsigned w) { return __uint_as_float(w & 0xffff0000u); }
__device__ __forceinline__ unsigned cvt_pk_bf16(float lo, float hi) { unsigned r; asm volatile("v_cvt_pk_bf16_f32 %0, %1, %2" : "=v"(r) : "v"(lo), "v"(hi)); return r; }

template <class Epi, class Sched>
__device__ __forceinline__ void gemm_phase(LAS unsigned char* lds, const Gemm g, const Sched& S, const Epi& E) {
    int tid = threadIdx.x; asm volatile("" : "+v"(tid));
    const int wid = __builtin_amdgcn_readfirstlane(tid >> 6), lane = tid & 63, wr = wid >> 2, wc = wid & 3, fr = lane & 15, fq = lane >> 4;
    int K = g.K; asm volatile("" : "+s"(K));
    const int nt = K / BK;
    unsigned voffA[2], voffB[2];
#pragma unroll
    for (int i = 0; i < 2; ++i) { int R, C; stage_rc(tid * 16 + i * 8192, R, C); const int Rb = Epi::PERM ? ((R & ~31) + perm32(R & 31)) : R;
        voffA[i] = (unsigned)(R * K + C) * 2u; voffB[i] = (unsigned)(Rb * K + C) * 2u; }
    const size_t kstep = (size_t)(BK * 2);
    const size_t hstep = (size_t)HALF * K * 2;
    const size_t tstep = 2 * hstep;
    const unsigned ldsw = (unsigned)wid * 1024u;
    const int aoff = lds_byte(wr * 64 + fr, fq * 8), boff = lds_byte(wc * 32 + fr, fq * 8);
#define PG8_SA(b, h) (((b) * 2 + (h)) * HTB)
#define PG8_SB(b, h) ((4 + (b) * 2 + (h)) * HTB)
#define PG8_STAGE(bufoff, gbase, voff) do { _Pragma("unroll") for (int _i = 0; _i < 2; ++_i) \
        __builtin_amdgcn_global_load_lds((const unsigned*)((const char*)(gbase) + (voff)[_i]), (LAS unsigned*)(lds + (bufoff) + ldsw + _i * 8192), 16, 0, 0); } while (0)
#define PG8_LDA(dst, b, h) do { _Pragma("unroll") for (int m = 0; m < 4; ++m) _Pragma("unroll") for (int k = 0; k < 2; ++k) dst[m][k] = *(const LAS bf16x8*)(lds + PG8_SA(b, h) + aoff + m * 2048 + k * 1024); } while (0)
#define PG8_LDB(dst, b, h) do { _Pragma("unroll") for (int n = 0; n < 2; ++n) _Pragma("unroll") for (int k = 0; k < 2; ++k) dst[n][k] = *(const LAS bf16x8*)(lds + PG8_SB(b, h) + boff + n * 2048 + k * 1024); } while (0)
#define PG8_MMA(ai, bj, At, Bt) do { __builtin_amdgcn_s_setprio(1); _Pragma("unroll") for (int m = 0; m < 4; ++m) _Pragma("unroll") for (int n = 0; n < 2; ++n) _Pragma("unroll") for (int k = 0; k < 2; ++k) \
        acc[ai][bj][m][n] = __builtin_amdgcn_mfma_f32_16x16x32_bf16(Bt[n][k], At[m][k], acc[ai][bj][m][n], 0, 0, 0); __builtin_amdgcn_s_setprio(0); } while (0)
#define PG8_WAIT_V(n) asm volatile("s_waitcnt vmcnt(" #n ")" ::: "memory")
#define PG8_WAIT_L(n) asm volatile("s_waitcnt lgkmcnt(" #n ")" ::: "memory")
#define PG8_BAR __builtin_amdgcn_s_barrier()
#define PG8_SCHED __builtin_amdgcn_sched_barrier(0)
    Unit cur, nxt; int ui = 0;
    if (!S.next(0, cur)) return;
    f32x4 acc[2][2][4][2];
#pragma unroll
    for (int a = 0; a < 2; ++a)
#pragma unroll
        for (int b = 0; b < 2; ++b)
#pragma unroll
            for (int m = 0; m < 4; ++m)
#pragma unroll
                for (int n = 0; n < 2; ++n) acc[a][b][m][n] = (f32x4){0.f, 0.f, 0.f, 0.f};
    bf16x8 At[4][2], B0[2][2], B1[2][2];
    const char* cA = (const char*)g.A + (size_t)cur.pm * tstep; const char* cB = (const char*)g.Bt + (size_t)cur.pn * tstep;
    S.a_ready(cur);
    PG8_STAGE(PG8_SB(0, 0), cB, voffB); PG8_STAGE(PG8_SB(0, 1), cB + hstep, voffB); PG8_STAGE(PG8_SA(0, 0), cA, voffA); PG8_STAGE(PG8_SA(0, 1), cA + hstep, voffA);
    if (wr == 1) PG8_BAR;
    PG8_WAIT_V(2); PG8_BAR;
    PG8_STAGE(PG8_SB(1, 0), cB + kstep, voffB); PG8_STAGE(PG8_SA(1, 0), cA + kstep, voffA); PG8_STAGE(PG8_SB(1, 1), cB + hstep + kstep, voffB);
    PG8_WAIT_V(6); PG8_BAR;
    for (;;) {
        const bool has_next = S.next(ui + 1, nxt);
        const char* nA = has_next ? (const char*)g.A + (size_t)nxt.pm * tstep : cA; const char* nB = has_next ? (const char*)g.Bt + (size_t)nxt.pn * tstep : cB;
        for (int t = 0; t < nt; t += 2) {
            const bool last = (t == nt - 2);
            const char* a1 = cA + (size_t)(t + 1) * kstep;
            const char* a2 = last ? nA : cA + (size_t)(t + 2) * kstep; const char* b2 = last ? nB : cB + (size_t)(t + 2) * kstep;
            const char* a3 = a2 + kstep; const char* b3 = b2 + kstep;
            if (last && has_next) S.a_ready(nxt);
            PG8_LDB(B0, 0, 0); PG8_LDB(B1, 0, 1); PG8_SCHED; PG8_LDA(At, 0, 0); PG8_STAGE(PG8_SA(1, 1), a1 + hstep, voffA);
            PG8_WAIT_V(8); PG8_WAIT_L(0); PG8_BAR; PG8_MMA(0, 0, At, B0); PG8_MMA(0, 1, At, B1); PG8_BAR; PG8_SCHED;
            PG8_LDA(At, 0, 1); PG8_STAGE(PG8_SB(0, 0), b2, voffB); PG8_STAGE(PG8_SB(0, 1), b2 + hstep, voffB); PG8_STAGE(PG8_SA(0, 0), a2, voffA);
            PG8_WAIT_V(8); PG8_WAIT_L(0); PG8_BAR; PG8_MMA(1, 0, At, B0); PG8_MMA(1, 1, At, B1); PG8_BAR; PG8_SCHED;
            PG8_LDB(B0, 1, 0); PG8_LDB(B1, 1, 1); PG8_SCHED; PG8_LDA(At, 1, 0); PG8_STAGE(PG8_SA(0, 1), a2 + hstep, voffA);
            PG8_WAIT_V(8); PG8_WAIT_L(0); PG8_BAR; PG8_MMA(0, 0, At, B0); PG8_MMA(0, 1, At, B1); PG8_BAR; PG8_SCHED;
            PG8_LDA(At, 1, 1); PG8_STAGE(PG8_SB(1, 0), b3, voffB); PG8_STAGE(PG8_SB(1, 1), b3 + hstep, voffB); PG8_STAGE(PG8_SA(1, 0), a3, voffA);
            PG8_WAIT_V(8); PG8_WAIT_L(0); PG8_BAR; PG8_MMA(1, 0, At, B0); PG8_MMA(1, 1, At, B1); PG8_BAR; PG8_SCHED;
        }
        if (wr == 0) PG8_BAR;
        E(acc, cur, wr, wc, fr, fq); S.done(cur);
        if (!has_next) break;
#pragma unroll
        for (int a = 0; a < 2; ++a)
#pragma unroll
            for (int b = 0; b < 2; ++b)
#pragma unroll
                for (int m = 0; m < 4; ++m)
#pragma unroll
                    for (int n = 0; n < 2; ++n) acc[a][b][m][n] = (f32x4){0.f, 0.f, 0.f, 0.f};
        cur = nxt; cA = nA; cB = nB; ++ui;
        if (wr == 1) PG8_BAR;
    }
    PG8_WAIT_V(0);
    PG8_BAR;
#undef PG8_SA
#undef PG8_SB
#undef PG8_STAGE
#undef PG8_LDA
#undef PG8_LDB
#undef PG8_MMA
#undef PG8_WAIT_V
#undef PG8_WAIT_L
#undef PG8_BAR
#undef PG8_SCHED
}

#define PG8_OPQ(p) asm volatile("" : "+v"(p))
template <int ACT  > struct EpiBf16 {
    static constexpr bool PERM = true;
    bf16_t* O; int ldc;
    __device__ __forceinline__ void operator()(const f32x4 (&acc)[2][2][4][2], const Unit& u, int wr, int wc, int fr, int fq) const {
        char* p = (char*)(O + (size_t)(wr * 64 + fr) * ldc + u.pn * BM + wc * 32 + 8 * fq);
        const size_t step = (size_t)16 * ldc * 2;
#pragma unroll
        for (int ai = 0; ai < 2; ++ai) {
#pragma unroll
            for (int m = 0; m < 4; ++m) {
                PG8_OPQ(p);
#pragma unroll
                for (int bj = 0; bj < 2; ++bj) { f32x4 v0 = acc[ai][bj][m][0], v1 = acc[ai][bj][m][1];
                    if (ACT == 1) {
#pragma unroll
                        for (int j = 0; j < 4; ++j) { const float a0 = fmaxf(v0[j], 0.f), a1 = fmaxf(v1[j], 0.f); v0[j] = a0 * a0; v1[j] = a1 * a1; } }
                    u32x4 w; w.x = cvt_pk_bf16(v0[0], v0[1]); w.y = cvt_pk_bf16(v0[2], v0[3]); w.z = cvt_pk_bf16(v1[0], v1[1]); w.w = cvt_pk_bf16(v1[2], v1[3]);
                    *(u32x4*)(p + bj * HALF * 2) = w; }
                p += step;
            }
            p += 4 * step;
        }
    }
};
struct EpiGlu {
    static constexpr bool PERM = true;
    const bf16_t* Y; int ldy; bf16_t* O; int ldc;
    __device__ __forceinline__ void operator()(const f32x4 (&acc)[2][2][4][2], const Unit& u, int wr, int wc, int fr, int fq) const {
        const int col0 = u.pn * BM + wc * 32 + 8 * fq;
        const char* py = (const char*)(Y + (size_t)(wr * 64 + fr) * ldy + col0);
        char* po = (char*)(O + (size_t)(wr * 64 + fr) * ldc + col0);
        const size_t sy = (size_t)16 * ldy * 2, so = (size_t)16 * ldc * 2;
#pragma unroll
        for (int ai = 0; ai < 2; ++ai) {
#pragma unroll
            for (int m = 0; m < 4; ++m) {
                PG8_OPQ(py); PG8_OPQ(po); asm volatile("" ::: "memory");
#pragma unroll
                for (int bj = 0; bj < 2; ++bj) { const f32x4 v0 = acc[ai][bj][m][0], v1 = acc[ai][bj][m][1];
                    const u32x4 yv = *(const u32x4*)(py + bj * HALF * 2);
                    u32x4 w;
                    w.x = cvt_pk_bf16(bflo_(yv.x) * __builtin_amdgcn_rcpf(1.f + __expf(-v0[0])), bfhi_(yv.x) * __builtin_amdgcn_rcpf(1.f + __expf(-v0[1])));
                    w.y = cvt_pk_bf16(bflo_(yv.y) * __builtin_amdgcn_rcpf(1.f + __expf(-v0[2])), bfhi_(yv.y) * __builtin_amdgcn_rcpf(1.f + __expf(-v0[3])));
                    w.z = cvt_pk_bf16(bflo_(yv.z) * __builtin_amdgcn_rcpf(1.f + __expf(-v1[0])), bfhi_(yv.z) * __builtin_amdgcn_rcpf(1.f + __expf(-v1[1])));
                    w.w = cvt_pk_bf16(bflo_(yv.w) * __builtin_amdgcn_rcpf(1.f + __expf(-v1[2])), bfhi_(yv.w) * __builtin_amdgcn_rcpf(1.f + __expf(-v1[3])));
                    *(u32x4*)(po + bj * HALF * 2) = w; }
                py += sy; po += so;
            }
            py += 4 * sy; po += 4 * so;
        }
    }
};
struct EpiRes {
    static constexpr bool PERM = true;
    bf16_t* HB; int ldc; float alpha;
    __device__ __forceinline__ void operator()(const f32x4 (&acc)[2][2][4][2], const Unit& u, int wr, int wc, int fr, int fq) const {
        char* p = (char*)(HB + (size_t)(wr * 64 + fr) * ldc + u.pn * BM + wc * 32 + 8 * fq);
        const size_t step = (size_t)16 * ldc * 2;
#pragma unroll
        for (int ai = 0; ai < 2; ++ai) {
#pragma unroll
            for (int m = 0; m < 4; ++m) {
                PG8_OPQ(p);
#pragma unroll
                for (int bj = 0; bj < 2; ++bj) { const f32x4 v0 = acc[ai][bj][m][0], v1 = acc[ai][bj][m][1];
                    const u32x4 h = *(const u32x4*)(p + bj * HALF * 2);
                    u32x4 w;
                    w.x = cvt_pk_bf16(bflo_(h.x) * alpha + v0[0], bfhi_(h.x) * alpha + v0[1]); w.y = cvt_pk_bf16(bflo_(h.y) * alpha + v0[2], bfhi_(h.y) * alpha + v0[3]);
                    w.z = cvt_pk_bf16(bflo_(h.z) * alpha + v1[0], bfhi_(h.z) * alpha + v1[1]); w.w = cvt_pk_bf16(bflo_(h.w) * alpha + v1[2], bfhi_(h.w) * alpha + v1[3]);
                    *(u32x4*)(p + bj * HALF * 2) = w; }
                p += step;
            }
            p += 4 * step;
        }
    }
};
}

constexpr int M_TOK = 65536, DM = 1024, DIN = 2320, DINP = 2560, DFF = 4096, NPANEL = 256, NLAYER = 2;
constexpr int C_S5U = 0, C_Q = 256, C_K = 512, C_V = 768, C_R = 1280, C_LX = 1792, C_LG = 2048, C_GZ = 2304, NZ_MAIN = 2304;
constexpr int ZROWB = DINP * 2;
constexpr float ALPHA = 1.4142135623730951f;
constexpr float LN_EPS = 1e-5f;
constexpr size_t MiB = 1u << 20;
constexpr size_t WS_WIN = 2 * MiB, WS_WOUT = 12 * MiB, WS_W1 = 16 * MiB, WS_W2 = 32 * MiB, WS_WGLU = 48 * MiB;
constexpr size_t WS_LRUW = 48 * MiB + 512 * 1024, WS_S5A = 49 * MiB, WS_S5M = 50 * MiB, WS_S5W = 56 * MiB;
constexpr size_t WS_LRUA = 58 * MiB, WS_LRUB = 58 * MiB + 256 * 1024, WS_S5H = 59 * MiB, WS_GLAD = 61 * MiB, WS_GLAS = 64 * MiB;
constexpr size_t WS_HB = 96 * MiB, WS_PANEL = 224 * MiB, PANEL_BYTES = 2 * MiB;
constexpr size_t WS_LRUAB = 736 * MiB, WS_LRUC = 800 * MiB, WS_GLAP = 808 * MiB, WS_GLAE = 936 * MiB, WS_END = 937 * MiB;
constexpr size_t P_Z = 0, P_MIX = 1310720, P_YS5 = 1310720 + 524288, P_HID = 0;
constexpr int LDS_BYTES = 147456;
constexpr int LDS_TA = 131072, LDS_TB = 131072 + 2048, LDS_XB = 131072 + 8192;

struct Args { const float* in[30]; float* out; unsigned char* ws; };
typedef const Args __attribute__((address_space(4))) CArgs;
__device__ __forceinline__ CArgs* kargs() { CArgs* p = (CArgs*)__builtin_amdgcn_kernarg_segment_ptr(); asm volatile("" : "+s"(p)); return p; }

__device__ __forceinline__ unsigned pk2(float lo, float hi) { unsigned r; asm("v_cvt_pk_bf16_f32 %0, %1, %2" : "=v"(r) : "v"(lo), "v"(hi)); return r; }
__device__ __forceinline__ unsigned f2bf(float f) { return pk2(f, f) & 0xffffu; }
__device__ __forceinline__ float bflo(unsigned w) { return __uint_as_float(w << 16); }
__device__ __forceinline__ float bfhi(unsigned w) { return __uint_as_float(w & 0xffff0000u); }
__device__ __forceinline__ float bf1(bf16_t v) { return __uint_as_float(((unsigned)v) << 16); }
__device__ __forceinline__ float sigmoidf_(float x) { return __builtin_amdgcn_rcpf(1.f + __expf(-x)); }
__device__ __forceinline__ float gelu_tanh(float x) { const float u = 0.7978845608028654f * (x + 0.044715f * x * x * x); return x * __builtin_amdgcn_rcpf(1.f + __expf(-2.f * u)); }
__device__ __forceinline__ void lds_fence() { asm volatile("s_waitcnt lgkmcnt(0)" ::: "memory"); }
__device__ __forceinline__ void block_fence() { __builtin_amdgcn_fence(__ATOMIC_RELEASE, "workgroup"); __syncthreads(); __builtin_amdgcn_fence(__ATOMIC_ACQUIRE, "workgroup"); }
__device__ __forceinline__ float wave_sum(float v) {
#pragma unroll
    for (int o = 1; o < 64; o <<= 1) v += __shfl_xor(v, o);
    return v;
}
__device__ __forceinline__ f32x4 mfma16(bf16x8 a, bf16x8 b, f32x4 c) { return __builtin_amdgcn_mfma_f32_16x16x32_bf16(a, b, c, 0, 0, 0); }

template <bool WIN_PERM = false  >
__device__ __forceinline__ void transpose_item(const float* W, int K, int N, int Npad, bf16_t* WT, LAS float* scr, int item, int lane) {
    const int nblk = Npad / 32, kb = item / nblk, nb = item % nblk, k0 = 64 * kb, n0 = 32 * nb;
    const int nn = n0 + (lane & 31);
    const int sc = !WIN_PERM ? nn : (nn < 1792 ? nn : (nn < 2304 ? nn + 16 : nn - 512));
#pragma unroll 8
    for (int i = 0; i < 32; ++i) { const int kk = 2 * i + (lane >> 5); scr[kk * 33 + (lane & 31)] = (nn < N) ? W[(size_t)(k0 + kk) * N + sc] : 0.f; }
    lds_fence();
    const int c = lane & 7;
#pragma unroll
    for (int j = 0; j < 4; ++j) { const int n = (lane >> 3) + 8 * j; const LAS float* s = scr + (8 * c) * 33 + n;
        u32x4 o; o.x = pk2(s[0 * 33], s[1 * 33]); o.y = pk2(s[2 * 33], s[3 * 33]); o.z = pk2(s[4 * 33], s[5 * 33]); o.w = pk2(s[6 * 33], s[7 * 33]);
        *(u32x4*)(WT + (size_t)(n0 + n) * K + k0 + 8 * c) = o; }
    lds_fence();
}
__device__ __forceinline__ void s5_pow(float lrdt, float rev1, float n, float& pr, float& pi) {
    const float mag = __expf(n * lrdt);
    const float r = n * rev1, rr = __builtin_fmaf(n, rev1, -r);
    const float fr_ = (r - rintf(r)) + rr;
    pr = mag * __builtin_amdgcn_cosf(fr_); pi = mag * __builtin_amdgcn_sinf(fr_);
}
struct S5Lane { float lrdt, rev1, fre, fim; };
__device__ __forceinline__ S5Lane s5_lane(CArgs& a, int l, int g, int p) {
    S5Lane s;
    const float dt = expf(a.in[6][l * 16 + g]);
    const float lr = fminf(a.in[4][(l * 16 + g) * 64 + p], -1e-4f), li = a.in[5][(l * 16 + g) * 64 + p];
    s.lrdt = lr * dt; const float ang = li * dt; s.rev1 = ang * 0.15915494309189535f;
    float ar, ai; s5_pow(s.lrdt, s.rev1, 1.f, ar, ai);
    const float den = lr * lr + li * li;
    s.fre = ((ar - 1.f) * lr + ai * li) / den; s.fim = (ai * lr - (ar - 1.f) * li) / den;
    return s;
}
__device__ __forceinline__ void s5_prep_k(CArgs& a, unsigned char* ws, LAS float* scr, int l, int g, int d, int lane) {
    const int p = lane; const S5Lane s = s5_lane(a, l, g, p);
    float pr, pi; s5_pow(s.lrdt, s.rev1, (float)d, pr, pi);
    const float* bre = a.in[7] + ((size_t)(l * 16 + g) * 64 + p) * 16; const float* bim = a.in[8] + ((size_t)(l * 16 + g) * 64 + p) * 16;
    const float* cre = a.in[9] + (size_t)(l * 16 + g) * 16 * 64 + p; const float* cim = a.in[10] + (size_t)(l * 16 + g) * 16 * 64 + p;
    for (int c = 0; c < 16; ++c) {
        const float cr = cre[c * 64], ci = cim[c * 64];
        scr[(0 * 16 + c) * 65 + p] = cr * pr - ci * pi; scr[(1 * 16 + c) * 65 + p] = cr * pi + ci * pr;
        const float br = bre[c], bi = bim[c];
        scr[(2 * 16 + c) * 65 + p] = s.fre * br - s.fim * bi; scr[(3 * 16 + c) * 65 + p] = s.fre * bi + s.fim * br;
    }
    lds_fence();
    bf16_t* Mg = (bf16_t*)(ws + WS_S5M) + (size_t)(l * 16 + g) * 64 * 192;
    for (int q = 0; q < 4; ++q) {
        const int idx = lane + 64 * q, co = idx >> 4, ci = idx & 15;
        float v = 0.f;
        for (int pp = 0; pp < 64; ++pp) v += scr[(0 * 16 + co) * 65 + pp] * scr[(2 * 16 + ci) * 65 + pp] - scr[(1 * 16 + co) * 65 + pp] * scr[(3 * 16 + ci) * 65 + pp];
        const bf16_t vb = (bf16_t)f2bf(v);
        for (int to = d; to < 4; ++to) {
            Mg[(size_t)(to * 16 + co) * 192 + (to - d) * 16 + ci] = vb;
            if (d > 0) Mg[(size_t)((to - d) * 16 + co) * 192 + to * 16 + ci] = 0;
        }
    }
    lds_fence();
}
__device__ __forceinline__ void s5_prep_vw(CArgs& a, unsigned char* ws, int l, int g, int lane) {
    const int p = lane; const S5Lane s = s5_lane(a, l, g, p);
    float* A = (float*)(ws + WS_S5A) + ((size_t)(l * 16 + g) * 64 + p) * 4;
    { float r4, i4, r256, i256; s5_pow(s.lrdt, s.rev1, 4.f, r4, i4); s5_pow(s.lrdt, s.rev1, 256.f, r256, i256); A[0] = r4; A[1] = i4; A[2] = r256; A[3] = i256; }
    const float* bre = a.in[7] + ((size_t)(l * 16 + g) * 64 + p) * 16; const float* bim = a.in[8] + ((size_t)(l * 16 + g) * 64 + p) * 16;
    const float* cre = a.in[9] + (size_t)(l * 16 + g) * 16 * 64 + p; const float* cim = a.in[10] + (size_t)(l * 16 + g) * 16 * 64 + p;
    bf16_t* Wg = (bf16_t*)(ws + WS_S5W) + (size_t)(l * 16 + g) * 128 * 64;
    bf16_t* Mg = (bf16_t*)(ws + WS_S5M) + (size_t)(l * 16 + g) * 64 * 192;
    float bbr[16], bbi[16], cr[16], ci[16];
#pragma unroll
    for (int c = 0; c < 16; ++c) { const float br = bre[c], bi = bim[c]; bbr[c] = s.fre * br - s.fim * bi; bbi[c] = s.fre * bi + s.fim * br; cr[c] = cre[c * 64]; ci[c] = cim[c * 64]; }
#pragma unroll 1
    for (int t = 0; t < 4; ++t) {
        float pr, pi; s5_pow(s.lrdt, s.rev1, (float)(3 - t), pr, pi);
        float qr, qi; s5_pow(s.lrdt, s.rev1, (float)(t + 1), qr, qi);
#pragma unroll
        for (int c = 0; c < 16; c += 2) {
            *(unsigned*)(Wg + (size_t)(2 * p) * 64 + t * 16 + c) = pk2(pr * bbr[c] - pi * bbi[c], pr * bbr[c + 1] - pi * bbi[c + 1]);
            *(unsigned*)(Wg + (size_t)(2 * p + 1) * 64 + t * 16 + c) = pk2(pr * bbi[c] + pi * bbr[c], pr * bbi[c + 1] + pi * bbr[c + 1]);
        }
#pragma unroll
        for (int c = 0; c < 16; ++c) {
            const float vr = cr[c] * qr - ci[c] * qi, vi = cr[c] * qi + ci[c] * qr;
            *(unsigned*)(Mg + (size_t)(t * 16 + c) * 192 + 64 + 2 * p) = pk2(vr, -vi);
        }
    }
}
__device__ __forceinline__ void ln_panel(const float* src, float* dst, bf16_t* dstb, const float* gam, const float* bet, LAS f32x2* T) {
    int tid_ = threadIdx.x; asm volatile("" : "+v"(tid_));
    const int lane = tid_ & 63, wave = __builtin_amdgcn_readfirstlane(tid_ >> 6);
    constexpr int NB = 2;
    f32x4 cur[NB][4], nxt[NB][4];
    const int r0 = wave * 32;
#pragma unroll
    for (int b = 0; b < NB; ++b)
#pragma unroll
        for (int j = 0; j < 4; ++j) cur[b][j] = ((const f32x4*)(src + (size_t)(r0 + b) * DM))[lane + 64 * j];
    f32x4 gv[4], bv[4];
#pragma unroll
    for (int j = 0; j < 4; ++j) { gv[j] = ((const f32x4*)gam)[lane + 64 * j]; bv[j] = ((const f32x4*)bet)[lane + 64 * j]; }
    for (int it = 0; it < 32 / NB; ++it) {
        const int r = r0 + it * NB;
        if (it + 1 < 32 / NB) {
#pragma unroll
            for (int b = 0; b < NB; ++b)
#pragma unroll
                for (int j = 0; j < 4; ++j) nxt[b][j] = ((const f32x4*)(src + (size_t)(r + NB + b) * DM))[lane + 64 * j];
        }
        float s[NB], s2[NB];
#pragma unroll
        for (int b = 0; b < NB; ++b) { s[b] = 0.f;
#pragma unroll
            for (int j = 0; j < 4; ++j) s[b] += (cur[b][j].x + cur[b][j].y) + (cur[b][j].z + cur[b][j].w); }
#pragma unroll
        for (int o = 1; o < 64; o <<= 1)
#pragma unroll
            for (int b = 0; b < NB; ++b) s[b] += __shfl_xor(s[b], o);
#pragma unroll
        for (int b = 0; b < NB; ++b) { const float mean = s[b] * (1.f / DM); s2[b] = 0.f;
#pragma unroll
            for (int j = 0; j < 4; ++j) { cur[b][j] = cur[b][j] - mean; s2[b] += (cur[b][j].x * cur[b][j].x + cur[b][j].y * cur[b][j].y) + (cur[b][j].z * cur[b][j].z + cur[b][j].w * cur[b][j].w); } }
#pragma unroll
        for (int o = 1; o < 64; o <<= 1)
#pragma unroll
            for (int b = 0; b < NB; ++b) s2[b] += __shfl_xor(s2[b], o);
#pragma unroll
        for (int b = 0; b < NB; ++b) {
            const float rstd = 1.f / sqrtf(s2[b] * (1.f / DM) + LN_EPS);
            if (T && lane == 0) T[r + b] = (f32x2){s[b] * (1.f / DM), rstd};
#pragma unroll
            for (int j = 0; j < 4; ++j) {
                const f32x4 o = cur[b][j] * rstd * gv[j] + bv[j];
                if (dst) ((f32x4*)(dst + (size_t)(r + b) * DM))[lane + 64 * j] = o;
                if (dstb) { u32x2 w; w.x = pk2(o.x, o.y); w.y = pk2(o.z, o.w); ((u32x2*)(dstb + (size_t)(r + b) * DM))[lane + 64 * j] = w; }
            }
        }
#pragma unroll
        for (int b = 0; b < NB; ++b)
#pragma unroll
            for (int j = 0; j < 4; ++j) cur[b][j] = nxt[b][j];
    }
}

__device__ __forceinline__ void ln_panel_b(bf16_t* hb, float* outf, const float* gam, const float* bet) {
    int tid_ = threadIdx.x; asm volatile("" : "+v"(tid_));
    const int lane = tid_ & 63, wave = __builtin_amdgcn_readfirstlane(tid_ >> 6);
    constexpr int NB = 2;
    u32x4 nxt[NB][2];
    const int r0 = wave * 32;
#pragma unroll
    for (int b = 0; b < NB; ++b)
#pragma unroll
        for (int j = 0; j < 2; ++j) nxt[b][j] = ((const u32x4*)(hb + (size_t)(r0 + b) * DM))[lane + 64 * j];
    f32x4 gv[2][2], bv[2][2];
#pragma unroll
    for (int j = 0; j < 2; ++j)
#pragma unroll
        for (int q = 0; q < 2; ++q) { gv[j][q] = *(const f32x4*)(gam + 512 * j + 8 * lane + 4 * q); bv[j][q] = *(const f32x4*)(bet + 512 * j + 8 * lane + 4 * q); }
    for (int it = 0; it < 32 / NB; ++it) {
        const int r = r0 + it * NB;
        float v[NB][16];
#pragma unroll
        for (int b = 0; b < NB; ++b)
#pragma unroll
            for (int j = 0; j < 2; ++j)
#pragma unroll
                for (int k = 0; k < 4; ++k) { v[b][8 * j + 2 * k] = bflo(nxt[b][j][k]); v[b][8 * j + 2 * k + 1] = bfhi(nxt[b][j][k]); }
        if (it + 1 < 32 / NB) {
#pragma unroll
            for (int b = 0; b < NB; ++b)
#pragma unroll
                for (int j = 0; j < 2; ++j) nxt[b][j] = ((const u32x4*)(hb + (size_t)(r + NB + b) * DM))[lane + 64 * j];
        }
        float s[NB], s2[NB];
#pragma unroll
        for (int b = 0; b < NB; ++b) { s[b] = 0.f;
#pragma unroll
            for (int k = 0; k < 16; ++k) s[b] += v[b][k]; }
#pragma unroll
        for (int o = 1; o < 64; o <<= 1)
#pragma unroll
            for (int b = 0; b < NB; ++b) s[b] += __shfl_xor(s[b], o);
#pragma unroll
        for (int b = 0; b < NB; ++b) { const float mean = s[b] * (1.f / DM); s2[b] = 0.f;
#pragma unroll
            for (int k = 0; k < 16; ++k) { v[b][k] -= mean; s2[b] += v[b][k] * v[b][k]; } }
#pragma unroll
        for (int o = 1; o < 64; o <<= 1)
#pragma unroll
            for (int b = 0; b < NB; ++b) s2[b] += __shfl_xor(s2[b], o);
#pragma unroll
        for (int b = 0; b < NB; ++b) {
            const float rstd = 1.f / sqrtf(s2[b] * (1.f / DM) + LN_EPS);
#pragma unroll
            for (int j = 0; j < 2; ++j) {
                float o[8];
#pragma unroll
                for (int k = 0; k < 8; ++k) o[k] = v[b][8 * j + k] * rstd * gv[j][k >> 2][k & 3] + bv[j][k >> 2][k & 3];
                if (outf) { f32x4* op = (f32x4*)(outf + (size_t)(r + b) * DM + 512 * j + 8 * lane); op[0] = (f32x4){o[0], o[1], o[2], o[3]}; op[1] = (f32x4){o[4], o[5], o[6], o[7]}; }
                else { u32x4 w; w.x = pk2(o[0], o[1]); w.y = pk2(o[2], o[3]); w.z = pk2(o[4], o[5]); w.w = pk2(o[6], o[7]); ((u32x4*)(hb + (size_t)(r + b) * DM))[lane + 64 * j] = w; }
            }
        }
    }
}

__device__ __forceinline__ void prologue(CArgs& a, LAS unsigned char* lds, int panel, int G) {
    int tid_ = threadIdx.x; asm volatile("" : "+v"(tid_));
    const int lane = tid_ & 63, wave = __builtin_amdgcn_readfirstlane(tid_ >> 6);
    unsigned char* ws = a.ws;
    LAS float* scr = (LAS float*)(lds + wave * 17408);
    const int gw = panel * 8 + wave, NGW = G * 8;
    constexpr int I_IN = (DM / 64) * (DINP / 32), I_OUT = (DM / 64) * (DM / 32), I_1 = (DM / 64) * (DFF / 32), I_2 = (DFF / 64) * (DM / 32), I_G = (256 / 64) * (256 / 32);
    constexpr int I_L = I_IN + I_OUT + I_1 + I_2 + I_G;
    for (int it = gw; it < NLAYER * I_L; it += NGW) {
        const int l = it / I_L; int r = it % I_L;
        if (r < I_IN) { transpose_item<true>(a.in[3] + (size_t)l * DM * DIN, DM, DIN, DINP, (bf16_t*)(ws + WS_WIN) + (size_t)l * DINP * DM, scr, r, lane); continue; } r -= I_IN;
        if (r < I_OUT) { transpose_item(a.in[23] + (size_t)l * DM * DM, DM, DM, DM, (bf16_t*)(ws + WS_WOUT) + (size_t)l * DM * DM, scr, r, lane); continue; } r -= I_OUT;
        if (r < I_1) { transpose_item(a.in[26] + (size_t)l * DM * DFF, DM, DFF, DFF, (bf16_t*)(ws + WS_W1) + (size_t)l * DFF * DM, scr, r, lane); continue; } r -= I_1;
        if (r < I_2) { transpose_item(a.in[27] + (size_t)l * DFF * DM, DFF, DM, DM, (bf16_t*)(ws + WS_W2) + (size_t)l * DM * DFF, scr, r, lane); continue; } r -= I_2;
        transpose_item(a.in[12] + (size_t)l * 256 * 256, 256, 256, 256, (bf16_t*)(ws + WS_WGLU) + (size_t)l * 256 * 256, scr, r, lane);
    }
    for (int it = NGW - 1 - gw; it < NLAYER * 16 * 5; it += NGW) {
        const int l = it / (16 * 5), r = it % (16 * 5), g = r / 5, d = r % 5;
        if (d < 4) s5_prep_k(a, ws, scr, l, g, d, lane); else s5_prep_vw(a, ws, l, g, lane);
    }
    for (int e = gw * 64 + lane; e < NLAYER * 2 * 8 * 1024; e += NGW * 64) {
        const int i = e & 31, j = (e >> 5) & 31, h = (e >> 10) & 7, which = (e >> 13) & 1, l = e >> 14;
        const float* w = a.in[which ? 20 : 18] + (size_t)(l * 8 + h) * 1024;
        ((bf16_t*)(ws + WS_LRUW))[e] = (bf16_t)f2bf(w[i * 32 + j]);
    }
    __syncthreads();
    ln_panel(a.in[0] + (size_t)panel * 256 * DM, nullptr, (bf16_t*)(ws + WS_HB) + (size_t)panel * 256 * DM, a.in[1], a.in[2], nullptr);
}

__device__ __forceinline__ void gz_phase(CArgs& a, int l, int panel) {
    int tid_ = threadIdx.x; asm volatile("" : "+v"(tid_));
    const int lane = tid_ & 63, wave = __builtin_amdgcn_readfirstlane(tid_ >> 6), fr = lane & 15, fq = lane >> 4;
    unsigned char* ws = a.ws;
    const bf16_t* Hb = (const bf16_t*)(ws + WS_HB) + (size_t)panel * 256 * DM + (size_t)(wave * 32 + fr) * DM + 8 * fq;
    const bf16_t* Wt = (const bf16_t*)(ws + WS_WIN) + (size_t)l * DINP * DM + (size_t)(C_GZ + fr) * DM + 8 * fq;
    f32x4 acc0 = (f32x4){0.f, 0.f, 0.f, 0.f}, acc1 = acc0;
#pragma unroll 8
    for (int ks = 0; ks < 32; ++ks) {
        const bf16x8 wf = *(const bf16x8*)(Wt + 32 * ks);
        acc0 = mfma16(wf, *(const bf16x8*)(Hb + 32 * ks), acc0);
        acc1 = mfma16(wf, *(const bf16x8*)(Hb + 16 * DM + 32 * ks), acc1);
    }
    unsigned char* Zp = ws + WS_PANEL + (size_t)panel * PANEL_BYTES + P_Z;
    u32x2 w0, w1; w0.x = pk2(acc0[0], acc0[1]); w0.y = pk2(acc0[2], acc0[3]); w1.x = pk2(acc1[0], acc1[1]); w1.y = pk2(acc1[2], acc1[3]);
    *(u32x2*)(Zp + (size_t)(wave * 32 + fr) * ZROWB + (C_GZ + 4 * fq) * 2) = w0;
    *(u32x2*)(Zp + (size_t)(wave * 32 + 16 + fr) * ZROWB + (C_GZ + 4 * fq) * 2) = w1;
}

template <int PASS>
__device__ __forceinline__ void lru_pass(CArgs& a, int l, int panel) {
    int tid_ = threadIdx.x; asm volatile("" : "+v"(tid_));
    const int lane = tid_ & 63, wave = tid_ >> 6;
    unsigned char* ws = a.ws;
    const int fr = lane & 15, fq = lane >> 4, h = wave, ch0 = h * 32 + 8 * fq;
    float cw[4][8], cb[8], br[8], bi[8], sp[8];
#pragma unroll
    for (int c = 0; c < 8; ++c) {
#pragma unroll
        for (int j = 0; j < 4; ++j) cw[j][c] = a.in[16][(size_t)(l * 4 + j) * 256 + ch0 + c];
        cb[c] = a.in[17][l * 256 + ch0 + c]; br[c] = a.in[19][l * 256 + ch0 + c]; bi[c] = a.in[21][l * 256 + ch0 + c];
        const float x = -a.in[22][l * 256 + ch0 + c];
        sp[c] = 8.f * (fmaxf(x, 0.f) + log1pf(expf(-fabsf(x))));
    }
    bf16x8 wrf[2], wif[2];
#pragma unroll
    for (int mt = 0; mt < 2; ++mt) { const int j = 8 * (fr >> 2) + 4 * mt + (fr & 3);
        wrf[mt] = *(const bf16x8*)((const bf16_t*)(ws + WS_LRUW) + (size_t)((l * 2 + 0) * 8 + h) * 1024 + j * 32 + 8 * fq);
        wif[mt] = *(const bf16x8*)((const bf16_t*)(ws + WS_LRUW) + (size_t)((l * 2 + 1) * 8 + h) * 1024 + j * 32 + 8 * fq); }
    const unsigned char* Zp = ws + WS_PANEL + (size_t)panel * PANEL_BYTES + P_Z;
    const unsigned char* Zprev = Zp - PANEL_BYTES;
    unsigned char* MIX = ws + WS_PANEL + (size_t)panel * PANEL_BYTES + P_MIX;
    const bool seq_start = (panel & 31) == 0;
    float hin[8], atot[8];
#pragma unroll
    for (int c = 0; c < 8; ++c) { hin[c] = (PASS == 2) ? ((const float*)(ws + WS_LRUB))[(size_t)panel * 256 + ch0 + c] : 0.f; atot[c] = 1.f; }
    u32x4 xn[4], gn = (u32x4){0u, 0u, 0u, 0u};
#define LRU_LOAD(tile_) do { const int t_ = (tile_) * 16 + fr; _Pragma("unroll") for (int j = 0; j < 4; ++j) { const int tt = t_ - 3 + j; xn[j] = (u32x4){0u, 0u, 0u, 0u}; \
            if (tt >= 0) xn[j] = *(const u32x4*)(Zp + (size_t)tt * ZROWB + (C_LX + ch0) * 2); \
            else if (!seq_start) xn[j] = *(const u32x4*)(Zprev + (size_t)(256 + tt) * ZROWB + (C_LX + ch0) * 2); } \
        if (PASS == 2) gn = *(const u32x4*)(Zp + (size_t)t_ * ZROWB + (C_LG + ch0) * 2); } while (0)
    LRU_LOAD(0);
    for (int tile = 0; tile < 16; ++tile) {
        const int t = tile * 16 + fr;
        float xc[8];
#pragma unroll
        for (int c = 0; c < 8; ++c) xc[c] = cb[c];
#pragma unroll
        for (int j = 0; j < 4; ++j) {
            const u32x4 xv = xn[j];
#pragma unroll
            for (int k = 0; k < 4; ++k) { xc[2 * k] += cw[j][2 * k] * bflo(xv[k]); xc[2 * k + 1] += cw[j][2 * k + 1] * bfhi(xv[k]); }
        }
        const u32x4 gv = gn;
        if (tile + 1 < 16) LRU_LOAD(tile + 1);
        u32x4 xp; xp.x = pk2(xc[0], xc[1]); xp.y = pk2(xc[2], xc[3]); xp.z = pk2(xc[4], xc[5]); xp.w = pk2(xc[6], xc[7]);
        const bf16x8 xcb = __builtin_bit_cast(bf16x8, xp);
        f32x4 ar[2], ai[2];
#pragma unroll
        for (int mt = 0; mt < 2; ++mt) { ar[mt] = mfma16(wrf[mt], xcb, (f32x4){0.f, 0.f, 0.f, 0.f}); ai[mt] = mfma16(wif[mt], xcb, (f32x4){0.f, 0.f, 0.f, 0.f}); }
        float A[8], B[8];
#pragma unroll
        for (int c = 0; c < 8; ++c) {
            const float gr = sigmoidf_(ar[c >> 2][c & 3] + br[c]), gi = sigmoidf_(ai[c >> 2][c & 3] + bi[c]);
            const float la = -gr * sp[c];
            const float x2 = 2.f * la;
            const float om = -x2 * (1.f + x2 * (0.5f + x2 * (0.16666667f + x2 * (0.041666668f + x2 * (0.0083333338f + x2 * 0.0013888889f)))));
            A[c] = __expf(la); B[c] = __builtin_amdgcn_sqrtf(fmaxf(om, 0.f)) * (gi * xc[c]);
        }
#pragma unroll
        for (int s = 1; s < 16; s <<= 1) {
#pragma unroll
            for (int c = 0; c < 8; ++c) { const float ap = __shfl_up(A[c], s, 16), bp = __shfl_up(B[c], s, 16);
                if (fr >= s) { B[c] = A[c] * bp + B[c]; A[c] = A[c] * ap; } }
        }
        if (PASS == 2) {
            float o[8];
#pragma unroll
            for (int k = 0; k < 4; ++k) { o[2 * k] = (A[2 * k] * hin[2 * k] + B[2 * k]) * gelu_tanh(bflo(gv[k])); o[2 * k + 1] = (A[2 * k + 1] * hin[2 * k + 1] + B[2 * k + 1]) * gelu_tanh(bfhi(gv[k])); }
            u32x4 w; w.x = pk2(o[0], o[1]); w.y = pk2(o[2], o[3]); w.z = pk2(o[4], o[5]); w.w = pk2(o[6], o[7]);
            *(u32x4*)(MIX + (size_t)t * 2048 + (768 + ch0) * 2) = w;
        }
        if (PASS == 1) {
            u32x4 w0, w1; w0.x = pk2(A[0], B[0]); w0.y = pk2(A[1], B[1]); w0.z = pk2(A[2], B[2]); w0.w = pk2(A[3], B[3]); w1.x = pk2(A[4], B[4]); w1.y = pk2(A[5], B[5]); w1.z = pk2(A[6], B[6]); w1.w = pk2(A[7], B[7]);
            u32x4* abp = (u32x4*)(ws + WS_LRUAB + (((size_t)panel * 256 + t) * 256 + ch0) * 4); abp[0] = w0; abp[1] = w1;
        }
        float a15[8], b15[8];
#pragma unroll
        for (int c = 0; c < 8; ++c) { a15[c] = __shfl(A[c], 15, 16); b15[c] = __shfl(B[c], 15, 16); hin[c] = a15[c] * hin[c] + b15[c]; atot[c] *= a15[c]; }
        if (PASS == 1 && fr == 0) {
            f32x4* cp = (f32x4*)(ws + WS_LRUC + (((size_t)panel * 16 + tile) * 256 + ch0) * 8);
            cp[0] = (f32x4){a15[0], b15[0], a15[1], b15[1]}; cp[1] = (f32x4){a15[2], b15[2], a15[3], b15[3]}; cp[2] = (f32x4){a15[4], b15[4], a15[5], b15[5]}; cp[3] = (f32x4){a15[6], b15[6], a15[7], b15[7]};
        }
    }
    if (PASS == 1 && fr == 0) {
#pragma unroll
        for (int c = 0; c < 8; ++c) { ((float*)(ws + WS_LRUA))[(size_t)panel * 256 + ch0 + c] = atot[c]; ((float*)(ws + WS_LRUB))[(size_t)panel * 256 + ch0 + c] = hin[c]; }
    }
}

__device__ __forceinline__ void lru_apply(CArgs& a, int l, int panel) {
    int tid_ = threadIdx.x; asm volatile("" : "+v"(tid_));
    const int lane = tid_ & 63, wave = tid_ >> 6;
    unsigned char* ws = a.ws;
    const int fr = lane & 15, fq = lane >> 4, ch0 = wave * 32 + 8 * fq;
    const unsigned char* Zp = ws + WS_PANEL + (size_t)panel * PANEL_BYTES + P_Z;
    unsigned char* MIX = ws + WS_PANEL + (size_t)panel * PANEL_BYTES + P_MIX;
    float hin[8];
#pragma unroll
    for (int c = 0; c < 8; ++c) hin[c] = ((const float*)(ws + WS_LRUB))[(size_t)panel * 256 + ch0 + c];
    u32x4 abn[2], gn; f32x4 cn[4];
#define LRU2_LOAD(tile_) do { const int t_ = (tile_) * 16 + fr; const u32x4* abp_ = (const u32x4*)(ws + WS_LRUAB + (((size_t)panel * 256 + t_) * 256 + ch0) * 4); abn[0] = abp_[0]; abn[1] = abp_[1]; \
        gn = *(const u32x4*)(Zp + (size_t)t_ * ZROWB + (C_LG + ch0) * 2); \
        const f32x4* cp_ = (const f32x4*)(ws + WS_LRUC + (((size_t)panel * 16 + (tile_)) * 256 + ch0) * 8); cn[0] = cp_[0]; cn[1] = cp_[1]; cn[2] = cp_[2]; cn[3] = cp_[3]; } while (0)
    LRU2_LOAD(0);
    for (int tile = 0; tile < 16; ++tile) {
        const int t = tile * 16 + fr;
        const u32x4 ab0 = abn[0], ab1 = abn[1], gv = gn; const f32x4 c0 = cn[0], c1 = cn[1], c2 = cn[2], c3 = cn[3];
        if (tile + 1 < 16) LRU2_LOAD(tile + 1);
        float o[8];
#pragma unroll
        for (int k = 0; k < 4; ++k) {
            o[k] = bflo(ab0[k]) * hin[k] + bfhi(ab0[k]); o[4 + k] = bflo(ab1[k]) * hin[4 + k] + bfhi(ab1[k]);
        }
#pragma unroll
        for (int k = 0; k < 4; ++k) { o[2 * k] *= gelu_tanh(bflo(gv[k])); o[2 * k + 1] *= gelu_tanh(bfhi(gv[k])); }
        u32x4 w; w.x = pk2(o[0], o[1]); w.y = pk2(o[2], o[3]); w.z = pk2(o[4], o[5]); w.w = pk2(o[6], o[7]);
        *(u32x4*)(MIX + (size_t)t * 2048 + (768 + ch0) * 2) = w;
        hin[0] = c0[0] * hin[0] + c0[1]; hin[1] = c0[2] * hin[1] + c0[3]; hin[2] = c1[0] * hin[2] + c1[1]; hin[3] = c1[2] * hin[3] + c1[3];
        hin[4] = c2[0] * hin[4] + c2[1]; hin[5] = c2[2] * hin[5] + c2[3]; hin[6] = c3[0] * hin[6] + c3[1]; hin[7] = c3[2] * hin[7] + c3[3];
    }
#undef LRU2_LOAD
}

template <int PASS>
__device__ __forceinline__ void s5_pass(CArgs& a, LAS unsigned char* lds, int l, int panel) {
    int tid_ = threadIdx.x; asm volatile("" : "+v"(tid_));
    const int lane = tid_ & 63, wave = __builtin_amdgcn_readfirstlane(tid_ >> 6);
    unsigned char* ws = a.ws;
    const int fr = lane & 15, fq = lane >> 4;
    LAS float* hl = (LAS float*)(lds + wave * 12288);
    LAS bf16_t* xh = (LAS bf16_t*)(lds + wave * 12288 + 8192);
    const unsigned char* Zp = ws + WS_PANEL + (size_t)panel * PANEL_BYTES + P_Z;
    unsigned char* YS5 = ws + WS_PANEL + (size_t)panel * PANEL_BYTES + P_YS5;
    for (int gi = 0; gi < 2; ++gi) {
        const int g = 2 * wave + gi;
        const bf16_t* Wg = (const bf16_t*)(ws + WS_S5W) + (size_t)(l * 16 + g) * 128 * 64;
        const bf16_t* Mg = (const bf16_t*)(ws + WS_S5M) + (size_t)(l * 16 + g) * 64 * 192;
        bf16x8 wf[8][2];
#pragma unroll
        for (int mt = 0; mt < 8; ++mt)
#pragma unroll
            for (int ks = 0; ks < 2; ++ks) wf[mt][ks] = *(const bf16x8*)(Wg + (size_t)(16 * mt + fr) * 64 + 32 * ks + 8 * fq);
        bf16x8 mf[4][4];
        f32x4 dsk = (f32x4){0.f, 0.f, 0.f, 0.f};
        if (PASS == 2) {
#pragma unroll
            for (int mt = 0; mt < 4; ++mt)
#pragma unroll
                for (int ks = 0; ks < 4; ++ks) mf[mt][ks] = *(const bf16x8*)(Mg + (size_t)(16 * mt + fr) * 192 + 64 + 32 * ks + 8 * fq);
            dsk = *(const f32x4*)(a.in[11] + l * 256 + g * 16 + 4 * fq);
        }
        const float* Ap = (const float*)(ws + WS_S5A) + ((size_t)(l * 16 + g) * 64 + lane) * 4;
        const float a4r = Ap[0], a4i = Ap[1];
        float* Hg = (float*)(ws + WS_S5H) + ((size_t)panel * 16 + g) * 128 + 2 * lane;
        float Hr = 0.f, Hi = 0.f;
        if (PASS == 2) { Hr = Hg[0]; Hi = Hg[1]; }
#pragma unroll 1
        for (int nt = 0; nt < 4; ++nt) {
            bf16x8 xf[2];
#pragma unroll
            for (int ks = 0; ks < 2; ++ks) xf[ks] = *(const bf16x8*)(Zp + (size_t)(64 * nt + 4 * fr + 2 * ks + (fq >> 1)) * ZROWB + (C_S5U + g * 16 + (fq & 1) * 8) * 2);
#pragma unroll
            for (int mt = 0; mt < 8; ++mt) {
                f32x4 acc = mfma16(wf[mt][0], xf[0], (f32x4){0.f, 0.f, 0.f, 0.f});
                acc = mfma16(wf[mt][1], xf[1], acc);
                *(LAS f32x4*)(hl + fr * 128 + 16 * mt + 4 * fq) = acc;
            }
            lds_fence();
            for (int j = 0; j < 16; ++j) {
                if (PASS == 2) *(LAS unsigned*)(xh + j * 128 + 2 * lane) = pk2(Hr, Hi);
                const f32x2 lc = *(LAS f32x2*)(hl + j * 128 + 2 * lane);
                const float nr = a4r * Hr - a4i * Hi + lc.x, ni = a4r * Hi + a4i * Hr + lc.y;
                Hr = nr; Hi = ni;
            }
            lds_fence();
            if (PASS == 2) {
                bf16x8 xhf[4];
#pragma unroll
                for (int k4 = 0; k4 < 4; ++k4) xhf[k4] = *(const LAS bf16x8*)(xh + fr * 128 + 32 * k4 + 8 * fq);
#pragma unroll
                for (int mt = 0; mt < 4; ++mt) {
                    f32x4 acc = (f32x4){0.f, 0.f, 0.f, 0.f};
#pragma unroll
                    for (int ks = 0; ks < 2; ++ks) if (2 * ks <= mt) acc = mfma16(*(const bf16x8*)(Mg + (size_t)(16 * mt + fr) * 192 + 32 * ks + 8 * fq), xf[ks], acc);
#pragma unroll
                    for (int k4 = 0; k4 < 4; ++k4) acc = mfma16(mf[mt][k4], xhf[k4], acc);
                    const int tok = (16 * nt + fr) * 4 + mt, ch = g * 16 + 4 * fq;
                    const u32x2 uv = *(const u32x2*)(Zp + (size_t)tok * ZROWB + (C_S5U + ch) * 2);
                    const float y0 = gelu_tanh(acc[0] + dsk[0] * bflo(uv.x)), y1 = gelu_tanh(acc[1] + dsk[1] * bfhi(uv.x));
                    const float y2 = gelu_tanh(acc[2] + dsk[2] * bflo(uv.y)), y3 = gelu_tanh(acc[3] + dsk[3] * bfhi(uv.y));
                    u32x2 w; w.x = pk2(y0, y1); w.y = pk2(y2, y3);
                    *(u32x2*)(YS5 + (size_t)tok * 512 + ch * 2) = w;
                }
            }
            lds_fence();
        }
        if (PASS == 1) { Hg[0] = Hr; Hg[1] = Hi; }
    }
}

constexpr int GL_QE = 0, GL_KE = 9216, GL_KDT = 18432, GL_VT = 27648, GL_SC = 46080, GL_ST = 55296, GL_GP = 73728, GL_SS = 75776, GL_DK = 76288, GL_X = 77824;
constexpr int GXS = 68;
constexpr int GRS = 144;
template <int PASS>
__device__ __forceinline__ void gla_pass(CArgs& a, LAS unsigned char* lds, int l, int panel) {
    int tid = threadIdx.x; asm volatile("" : "+v"(tid));
    const int lane = tid & 63, wave = tid >> 6;
    unsigned char* ws = a.ws;
    const int fr = lane & 15, fq = lane >> 4;
    const int d_ = lane, tq = wave;
    const int e_ = tid & 127, tq4 = tid >> 7;
    const int wq = wave & 3, wh = wave >> 2;
    const unsigned char* Zp = ws + WS_PANEL + (size_t)panel * PANEL_BYTES + P_Z;
    unsigned char* MIX = ws + WS_PANEL + (size_t)panel * PANEL_BYTES + P_MIX;
    LAS float* GP = (LAS float*)(lds + GL_GP); LAS float* SS = (LAS float*)(lds + GL_SS); LAS float* DK = (LAS float*)(lds + GL_DK);
    u32x4 pgz[2]; bf16_t pq[8], pk[8]; unsigned pv[8]; u32x2 pr[4]; u32x4 ppk[4]; float pet = 0.f;
#define GLA_LOAD(it_) do { const int h_ = (it_) >> 2, row0_ = ((it_) & 3) * 64; \
        if (PASS == 1) { _Pragma("unroll") for (int i = 0; i < 2; ++i) { pgz[i] = (u32x4){0u, 0u, 0u, 0u}; if (fq < 2) pgz[i] = *(const u32x4*)(Zp + (size_t)(row0_ + 16 * (2 * wh + i) + fr) * ZROWB + (C_GZ + 8 * fq) * 2); } } \
        else { const u32x4* pp_ = (const u32x4*)(ws + WS_GLAP + (((size_t)panel * 16 + (it_)) * 8 + tq) * 4096) + d_; ppk[0] = pp_[0]; ppk[1] = pp_[64]; ppk[2] = pp_[128]; ppk[3] = pp_[192]; \
               pet = ((const float*)(ws + WS_GLAE))[((size_t)panel * 16 + (it_)) * 64 + d_]; } \
        _Pragma("unroll") for (int i = 0; i < 8; ++i) { const unsigned char* zr = Zp + (size_t)(row0_ + tq * 8 + i) * ZROWB; \
            if (PASS == 2) pq[i] = *(const bf16_t*)(zr + (C_Q + h_ * 64 + d_) * 2); else pk[i] = *(const bf16_t*)(zr + (C_K + h_ * 64 + d_) * 2); } \
        _Pragma("unroll") for (int i = 0; i < 8; ++i) { \
            const unsigned short v0 = *(const bf16_t*)(Zp + (size_t)(row0_ + tq4 * 16 + 2 * i) * ZROWB + (C_V + h_ * 128 + e_) * 2); \
            const unsigned short v1 = *(const bf16_t*)(Zp + (size_t)(row0_ + tq4 * 16 + 2 * i + 1) * ZROWB + (C_V + h_ * 128 + e_) * 2); \
            pv[i] = (unsigned)v0 | ((unsigned)v1 << 16); } \
        if (PASS == 2) { _Pragma("unroll") for (int k = 0; k < 4; ++k) pr[k] = *(const u32x2*)(Zp + (size_t)(row0_ + 16 * wq + fr) * ZROWB + (C_R + h_ * 128 + 16 * (wh * 4 + k) + 4 * fq) * 2); } } while (0)
    GLA_LOAD(0);
    float bg = 0.f; f32x4 st[4]; float dprod = 1.f;
#pragma unroll
    for (int k = 0; k < 4; ++k) st[k] = (f32x4){0.f, 0.f, 0.f, 0.f};
    float* Sg = (float*)(ws + WS_GLAS) + ((size_t)panel * 4) * 8192;
    bf16x8 wfr = (bf16x8){0, 0, 0, 0, 0, 0, 0, 0};
#define GLA_WFRAG(h_) do { u32x4 w_ = (u32x4){0u, 0u, 0u, 0u}; if (fq < 2) { const float* wp_ = a.in[13] + (size_t)(l * 16 + 8 * fq) * 256 + (h_) * 64 + 16 * wq + fr; \
        w_.x = pk2(wp_[0], wp_[256]); w_.y = pk2(wp_[512], wp_[768]); w_.z = pk2(wp_[1024], wp_[1280]); w_.w = pk2(wp_[1536], wp_[1792]); } wfr = __builtin_bit_cast(bf16x8, w_); } while (0)
#define GLA_XTILE(g0_, g1_) do { const f32x4 x0_ = mfma16(wfr, __builtin_bit_cast(bf16x8, g0_), (f32x4){0.f, 0.f, 0.f, 0.f}), x1_ = mfma16(wfr, __builtin_bit_cast(bf16x8, g1_), (f32x4){0.f, 0.f, 0.f, 0.f}); \
        *(LAS f32x4*)(lds + GL_X + ((16 * (2 * wh) + fr) * GXS + 16 * wq + 4 * fq) * 4) = x0_; *(LAS f32x4*)(lds + GL_X + ((16 * (2 * wh + 1) + fr) * GXS + 16 * wq + 4 * fq) * 4) = x1_; } while (0)
    if (PASS == 1) { GLA_WFRAG(0); GLA_XTILE(pgz[0], pgz[1]); }
    __syncthreads();
#pragma unroll 1
    for (int it = 0; it < 16; ++it) {
        const int h = it >> 2, c = it & 3, row0 = c * 64;
        if (c == 0) {
            bg = a.in[14][l * 256 + h * 64 + d_];
            Sg = (float*)(ws + WS_GLAS) + ((size_t)panel * 4 + h) * 8192;
#pragma unroll
            for (int k = 0; k < 4; ++k) {
                const int et = wh * 4 + k;
#pragma unroll
                for (int r = 0; r < 4; ++r) {
                    const int e = 16 * et + 4 * fq + r, d = 16 * wq + fr;
                    if (PASS == 2) { const float v = Sg[e * 64 + d]; st[k][r] = v; *(LAS bf16_t*)(lds + GL_ST + e * GRS + d * 2) = (bf16_t)f2bf(v); }
                    else st[k][r] = 0.f;
                }
            }
            dprod = 1.f;
        }
        float qv[8], kv[8]; unsigned vpk[8]; u32x2 rvv[4];
#pragma unroll
        for (int i = 0; i < 8; ++i) { qv[i] = (PASS == 2) ? bf1(pq[i]) : 0.f; kv[i] = (PASS == 1) ? bf1(pk[i]) : 0.f; vpk[i] = pv[i]; }
        u32x4 cpk[4]; cpk[0] = ppk[0]; cpk[1] = ppk[1]; cpk[2] = ppk[2]; cpk[3] = ppk[3]; const float cet = pet;
#pragma unroll
        for (int k = 0; k < 4; ++k) rvv[k] = pr[k];
        if (it + 1 < 16) GLA_LOAD(it + 1);
        if (PASS == 1) {
            float gl[8];
#pragma unroll
            for (int i = 0; i < 8; ++i) {
                const float x = bg + *(const LAS float*)(lds + GL_X + ((tq * 8 + i) * GXS + d_) * 4);
                const float ls = fminf(x, 0.f) - __logf(1.f + __expf(-fabsf(x)));
                gl[i] = ls * 0.0625f + (i ? gl[i - 1] : 0.f);
            }
            GP[tq * 64 + d_] = gl[7];
            __syncthreads();
            float off = 0.f, tot = 0.f;
#pragma unroll
            for (int k = 0; k < 8; ++k) { const float v = GP[k * 64 + d_]; tot += v; if (k < tq) off += v; }
            const float etot = __expf(tot);
            float eb[8]; unsigned kk[8];
#pragma unroll
            for (int i = 0; i < 8; ++i) { eb[i] = __expf(off + gl[i]); const float ke = kv[i] * __builtin_amdgcn_rcpf(eb[i]); kk[i] = pk2(ke, ke * etot); }
            { u32x4 w; w.x = (kk[0] >> 16) | (kk[1] & 0xffff0000u); w.y = (kk[2] >> 16) | (kk[3] & 0xffff0000u); w.z = (kk[4] >> 16) | (kk[5] & 0xffff0000u); w.w = (kk[6] >> 16) | (kk[7] & 0xffff0000u);
              *(LAS u32x4*)(lds + GL_KDT + d_ * GRS + tq * 16) = w; }
            if (tq == 0) { DK[d_] = etot; ((float*)(ws + WS_GLAE))[((size_t)panel * 16 + it) * 64 + d_] = etot; }
            u32x4* pp = (u32x4*)(ws + WS_GLAP + (((size_t)panel * 16 + it) * 8 + tq) * 4096) + d_;
            pp[0] = (u32x4){__float_as_uint(eb[0]), __float_as_uint(eb[1]), __float_as_uint(eb[2]), __float_as_uint(eb[3])};
            pp[64] = (u32x4){__float_as_uint(eb[4]), __float_as_uint(eb[5]), __float_as_uint(eb[6]), __float_as_uint(eb[7])};
            pp[128] = (u32x4){kk[0], kk[1], kk[2], kk[3]}; pp[192] = (u32x4){kk[4], kk[5], kk[6], kk[7]};
        } else {
#pragma unroll
            for (int i = 0; i < 8; ++i) {
                const float eb = __uint_as_float(cpk[i >> 2][i & 3]); const unsigned kk = cpk[2 + (i >> 2)][i & 3];
                *(LAS bf16_t*)(lds + GL_QE + (tq * 8 + i) * GRS + d_ * 2) = (bf16_t)f2bf(qv[i] * 0.125f * eb);
                *(LAS bf16_t*)(lds + GL_KE + (tq * 8 + i) * GRS + d_ * 2) = (bf16_t)(kk & 0xffffu);
            }
            { u32x4 w; w.x = (cpk[2][0] >> 16) | (cpk[2][1] & 0xffff0000u); w.y = (cpk[2][2] >> 16) | (cpk[2][3] & 0xffff0000u); w.z = (cpk[3][0] >> 16) | (cpk[3][1] & 0xffff0000u); w.w = (cpk[3][2] >> 16) | (cpk[3][3] & 0xffff0000u);
              *(LAS u32x4*)(lds + GL_KDT + d_ * GRS + tq * 16) = w; }
            if (tq == 0) DK[d_] = cet;
        }
        { u32x4 w0, w1; w0.x = vpk[0]; w0.y = vpk[1]; w0.z = vpk[2]; w0.w = vpk[3]; w1.x = vpk[4]; w1.y = vpk[5]; w1.z = vpk[6]; w1.w = vpk[7];
          *(LAS u32x4*)(lds + GL_VT + e_ * GRS + tq4 * 32) = w0; *(LAS u32x4*)(lds + GL_VT + e_ * GRS + tq4 * 32 + 16) = w1; }
        __syncthreads();
        f32x4 o[4];
        if (PASS == 2) {
#pragma unroll
            for (int jj = 0; jj < 2; ++jj) {
                const int jt = 2 * wh + jj;
                f32x4 acc = (f32x4){0.f, 0.f, 0.f, 0.f};
#pragma unroll
                for (int ks = 0; ks < 2; ++ks) acc = mfma16(*(const LAS bf16x8*)(lds + GL_KE + (16 * jt + fr) * GRS + (32 * ks + 8 * fq) * 2),
                                                            *(const LAS bf16x8*)(lds + GL_QE + (16 * wq + fr) * GRS + (32 * ks + 8 * fq) * 2), acc);
                const int i = 16 * wq + fr, j0 = 16 * jt + 4 * fq;
                u32x2 w; w.x = pk2(j0 <= i ? acc[0] : 0.f, j0 + 1 <= i ? acc[1] : 0.f); w.y = pk2(j0 + 2 <= i ? acc[2] : 0.f, j0 + 3 <= i ? acc[3] : 0.f);
                *(LAS u32x2*)(lds + GL_SC + i * GRS + j0 * 2) = w;
            }
            __syncthreads();
            float ss = 0.f;
#pragma unroll
            for (int k = 0; k < 4; ++k) {
                const int et = wh * 4 + k;
                f32x4 acc = (f32x4){0.f, 0.f, 0.f, 0.f};
#pragma unroll
                for (int ks = 0; ks < 2; ++ks) {
                    if (ks == 0 || wq >= 2) acc = mfma16(*(const LAS bf16x8*)(lds + GL_VT + (16 * et + fr) * GRS + (32 * ks + 8 * fq) * 2),
                                                         *(const LAS bf16x8*)(lds + GL_SC + (16 * wq + fr) * GRS + (32 * ks + 8 * fq) * 2), acc);
                }
#pragma unroll
                for (int ks = 0; ks < 2; ++ks) acc = mfma16(*(const LAS bf16x8*)(lds + GL_ST + (16 * et + fr) * GRS + (32 * ks + 8 * fq) * 2),
                                                            *(const LAS bf16x8*)(lds + GL_QE + (16 * wq + fr) * GRS + (32 * ks + 8 * fq) * 2), acc);
                o[k] = acc; ss += (acc[0] * acc[0] + acc[1] * acc[1]) + (acc[2] * acc[2] + acc[3] * acc[3]);
            }
            ss += __shfl_xor(ss, 16); ss += __shfl_xor(ss, 32);
            if (fq == 0) SS[(16 * wq + fr) * 2 + wh] = ss;
        }
        {
            const float dk = DK[16 * wq + fr];
            dprod *= dk;
#pragma unroll
            for (int k = 0; k < 4; ++k) {
                const int et = wh * 4 + k;
                f32x4 acc = st[k] * dk;
#pragma unroll
                for (int ks = 0; ks < 2; ++ks) acc = mfma16(*(const LAS bf16x8*)(lds + GL_VT + (16 * et + fr) * GRS + (32 * ks + 8 * fq) * 2),
                                                            *(const LAS bf16x8*)(lds + GL_KDT + (16 * wq + fr) * GRS + (32 * ks + 8 * fq) * 2), acc);
                st[k] = acc;
            }
        }
        if (PASS == 1 && it + 1 < 16) {
            if (c == 3) GLA_WFRAG(h + 1);
            GLA_XTILE(pgz[0], pgz[1]);
        }
        __syncthreads();
        if (PASS == 2) {
            const int i = 16 * wq + fr;
            const float rs = rsqrtf((SS[i * 2] + SS[i * 2 + 1]) * (1.f / 128.f) + 1e-6f);
#pragma unroll
            for (int k = 0; k < 4; ++k) {
                const int e0 = 16 * (wh * 4 + k) + 4 * fq;
                const f32x4 ng = *(const f32x4*)(a.in[15] + l * 128 + e0);
                const u32x2 rv = rvv[k];
                const float r0 = bflo(rv.x), r1 = bfhi(rv.x), r2 = bflo(rv.y), r3 = bfhi(rv.y);
                u32x2 w; w.x = pk2(o[k][0] * rs * ng[0] * r0 * sigmoidf_(r0), o[k][1] * rs * ng[1] * r1 * sigmoidf_(r1));
                w.y = pk2(o[k][2] * rs * ng[2] * r2 * sigmoidf_(r2), o[k][3] * rs * ng[3] * r3 * sigmoidf_(r3));
                *(u32x2*)(MIX + (size_t)(row0 + i) * 2048 + (256 + h * 128 + e0) * 2) = w;
                { const unsigned s01 = pk2(st[k][0], st[k][1]), s23 = pk2(st[k][2], st[k][3]);
                  *(LAS bf16_t*)(lds + GL_ST + (e0 + 0) * GRS + (16 * wq + fr) * 2) = (bf16_t)(s01 & 0xffffu); *(LAS bf16_t*)(lds + GL_ST + (e0 + 1) * GRS + (16 * wq + fr) * 2) = (bf16_t)(s01 >> 16);
                  *(LAS bf16_t*)(lds + GL_ST + (e0 + 2) * GRS + (16 * wq + fr) * 2) = (bf16_t)(s23 & 0xffffu); *(LAS bf16_t*)(lds + GL_ST + (e0 + 3) * GRS + (16 * wq + fr) * 2) = (bf16_t)(s23 >> 16); }
            }
        }
        if (c == 3) {
            if (PASS == 1) {
#pragma unroll
                for (int k = 0; k < 4; ++k)
#pragma unroll
                    for (int r = 0; r < 4; ++r) Sg[(16 * (wh * 4 + k) + 4 * fq + r) * 64 + 16 * wq + fr] = st[k][r];
                if (wh == 0 && fq == 0) ((float*)(ws + WS_GLAD))[((size_t)panel * 4 + h) * 64 + 16 * wq + fr] = dprod;
            }
            __syncthreads();
        }
    }
#undef GLA_LOAD
#undef GLA_WFRAG
#undef GLA_XTILE
}

__device__ __forceinline__ void scan_phase(CArgs& a, int l) {
    int tid = threadIdx.x; asm volatile("" : "+v"(tid));
    unsigned char* ws = a.ws;
    const int gt = blockIdx.x * 512 + tid;
    for (int idx = gt; idx < 8 * 32768; idx += 131072) {
        const int b = idx >> 15, r = idx & 32767, hh = r >> 13, d = r & 63;
        float* S = (float*)(ws + WS_GLAS) + (size_t)(b * 32) * 32768 + r;
        const float* D = (const float*)(ws + WS_GLAD) + (size_t)(b * 32) * 256 + hh * 64 + d;
        float loc[32], dec[32];
#pragma unroll
        for (int s = 0; s < 32; ++s) { loc[s] = S[(size_t)s * 32768]; dec[s] = D[(size_t)s * 256]; }
        float run = 0.f;
#pragma unroll
        for (int s = 0; s < 32; ++s) { S[(size_t)s * 32768] = run; run = dec[s] * run + loc[s]; }
    }
    if (gt < 2048) {
        const int b = gt >> 8, ch = gt & 255;
        float* B = (float*)(ws + WS_LRUB) + (size_t)(b * 32) * 256 + ch; const float* A = (const float*)(ws + WS_LRUA) + (size_t)(b * 32) * 256 + ch;
        float run = 0.f;
        for (int s = 0; s < 32; ++s) { const float loc = B[s * 256], dec = A[s * 256]; B[s * 256] = run; run = dec * run + loc; }
    } else if (gt >= 4096 && gt < 4096 + 8192) {
        const int q = gt - 4096, b = q >> 10, g = (q >> 6) & 15, p = q & 63;
        const float* Ap = (const float*)(ws + WS_S5A) + ((size_t)(l * 16 + g) * 64 + p) * 4;
        const float ar = Ap[2], ai = Ap[3];
        float* H = (float*)(ws + WS_S5H) + ((size_t)(b * 32) * 16 + g) * 128 + 2 * p;
        float rr = 0.f, ri = 0.f;
        for (int s = 0; s < 32; ++s) { const float lr = H[(size_t)s * 2048], li = H[(size_t)s * 2048 + 1]; H[(size_t)s * 2048] = rr; H[(size_t)s * 2048 + 1] = ri;
            const float nr = ar * rr - ai * ri + lr, ni = ar * ri + ai * rr + li; rr = nr; ri = ni; }
    }
}

#define XB_TMO      128
#define XB_XCNT(j)  (256  + 64 * (j))
#define XB_XSUB(j)  (1280 + 64 * (j))
#define XB_XGEN(j)  (2304 + 64 * (j))
#define XB_TOP      3328
#define XB_TOPGEN   3392
#define XCD_BAR_WORDS 3456
#define XB_SPIN_CAP (1u << 18)

__device__ __forceinline__ unsigned xb_ld(unsigned* p)              { return __hip_atomic_load(p, __ATOMIC_RELAXED, __HIP_MEMORY_SCOPE_AGENT); }
__device__ __forceinline__ unsigned xb_add(unsigned* p, unsigned v) { return __hip_atomic_fetch_add(p, v, __ATOMIC_RELAXED, __HIP_MEMORY_SCOPE_AGENT); }
__device__ __forceinline__ unsigned xb_xcc_id() { return (unsigned)__builtin_amdgcn_s_getreg((3 << 11) | 20) & 0xFu; }
#define XB_SPIN(cond, bar) do { unsigned _sp = 0; while (cond) { __builtin_amdgcn_s_sleep(1); \
    if ((++_sp & 255u) == 0u) { if (xb_ld(&(bar)[XB_TMO])) break; if (_sp > XB_SPIN_CAP) { atomicAdd(&(bar)[XB_TMO], 1u); break; } } } } while (0)

struct XcdBarrier {
    unsigned* bar; unsigned x;
    volatile LAS unsigned* st;
};

__device__ __forceinline__ XcdBarrier xcd_barrier_post(unsigned* bar, volatile LAS unsigned* st) {
    XcdBarrier b; b.bar = bar; b.x = xb_xcc_id(); b.st = st;
    if (threadIdx.x == 0) (void)xb_add(&bar[XB_XCNT(b.x)], 1u);
    return b;
}
__device__ __forceinline__ void xcd_barrier_complete(unsigned* bar, unsigned x, unsigned& nloc, unsigned& nx) {
    const unsigned G = gridDim.x * gridDim.y * gridDim.z;
    unsigned sum, cnt, mine, sp = 0u;
    for (;;) {
        sum = 0u; cnt = 0u; mine = 0u;
#pragma unroll
        for (unsigned j = 0; j < 16; ++j) { const unsigned c = xb_ld(&bar[XB_XCNT(j)]); sum += c; cnt += (c > 0u) ? 1u : 0u; mine = (j == x) ? c : mine; }
        if (sum == G) break;
        __builtin_amdgcn_s_sleep(1);
        if ((++sp & 255u) == 0u) { if (xb_ld(&bar[XB_TMO])) break; if (sp > XB_SPIN_CAP) { atomicAdd(&bar[XB_TMO], 1u); break; } }
    }
    nloc = mine > 0u ? mine : 1u; nx = cnt > 0u ? cnt : 1u;
}

__device__ __forceinline__ void xcd_barrier(const XcdBarrier& b) {
    asm volatile("s_waitcnt vmcnt(0)" ::: "memory");
    __syncthreads();
    if (threadIdx.x == 0) {
        unsigned* bar = b.bar;
        __builtin_amdgcn_s_waitcnt(0);
        unsigned nloc = b.st[0], nx = b.st[1];
        if (nloc == 0u) { xcd_barrier_complete(bar, b.x, nloc, nx); b.st[0] = nloc; b.st[1] = nx; }
        const unsigned old = xb_add(&bar[XB_XSUB(b.x)], 1u);
        const unsigned gen = old / nloc;
        if (old + 1u == (gen + 1u) * nloc) {
            __builtin_amdgcn_fence(__ATOMIC_RELEASE, "agent");
            asm volatile("s_waitcnt vmcnt(0)" ::: "memory");
            const unsigned og = xb_add(&bar[XB_TOP], 1u);
            const unsigned tg = og / nx;
            if (og + 1u == (tg + 1u) * nx) xb_add(&bar[XB_TOPGEN], 1u);
            else XB_SPIN(xb_ld(&bar[XB_TOPGEN]) == tg, bar);
            __builtin_amdgcn_fence(__ATOMIC_ACQUIRE, "agent");
            xb_add(&bar[XB_XGEN(b.x)], 1u);
            asm volatile("s_waitcnt vmcnt(0)" ::: "memory");
        } else {
            XB_SPIN(xb_ld(&bar[XB_XGEN(b.x)]) == gen, bar);
            __builtin_amdgcn_fence(__ATOMIC_ACQUIRE, "agent");
            asm volatile("s_waitcnt vmcnt(0)" ::: "memory");
        }
    }
    __syncthreads();
}


__global__ void __launch_bounds__(512, 2) fwd_megakernel(Args a) {
    extern __shared__ __attribute__((aligned(16))) unsigned char lds_raw[];
    LAS unsigned char* lds = (LAS unsigned char*)lds_raw;
    cg::grid_group grid = cg::this_grid();
    const int panel = blockIdx.x;
    if (threadIdx.x < 2) ((LAS unsigned*)(lds + LDS_XB))[threadIdx.x] = 0u;
    __syncthreads();
    const XcdBarrier xbar = xcd_barrier_post((unsigned*)kargs()->ws, (volatile LAS unsigned*)(lds + LDS_XB));
#define PHASE_PTRS() CArgs* ka = kargs(); unsigned char* ws = ka->ws; unsigned char* PB = ws + WS_PANEL + (size_t)panel * PANEL_BYTES; \
        bf16_t* HBp = (bf16_t*)(ws + WS_HB) + (size_t)panel * 256 * DM; float* Hp = ka->out + (size_t)panel * 256 * DM; (void)PB; (void)HBp; (void)Hp

#ifndef NO_PRO
    prologue(*kargs(), lds, panel, (int)gridDim.x);
#endif
    grid.sync();

#ifdef ONE_LAYER
    for (int l = 0; l < 1; ++l) {
#else
    for (int l = 0; l < NLAYER; ++l) {
#endif
        gz_phase(*kargs(), l, panel);
        {
            PHASE_PTRS();
            pg8::Gemm g{HBp, (const bf16_t*)(ws + WS_WIN) + (size_t)l * DINP * DM, DM}; pg8::PanelOrder S{NZ_MAIN / 256};
            pg8::EpiBf16<0> E{(bf16_t*)(PB + P_Z), DINP};
#ifndef NO_G1
            pg8::gemm_phase(lds, g, S, E);
#if REP_GEMM
            block_fence(); pg8::gemm_phase(lds, g, S, E);
#endif
#endif
        }
        xcd_barrier(xbar);
#ifndef NO_LRU
        lru_pass<1>(*kargs(), l, panel);
#endif
#ifndef NO_S5
        s5_pass<1>(*kargs(), lds, l, panel);
#endif
        __syncthreads();
#ifndef NO_GLA
        gla_pass<1>(*kargs(), lds, l, panel);
#endif
#if REP_MIX
        __syncthreads(); lru_pass<1>(*kargs(), l, panel); s5_pass<1>(*kargs(), lds, l, panel); __syncthreads(); gla_pass<1>(*kargs(), lds, l, panel);
#endif
#if REP_GLA
        __syncthreads(); gla_pass<1>(*kargs(), lds, l, panel);
#endif
#if REP_S5
        __syncthreads(); s5_pass<1>(*kargs(), lds, l, panel); __syncthreads();
#endif
        xcd_barrier(xbar);
#ifndef NO_SCAN
        scan_phase(*kargs(), l);
#endif
        xcd_barrier(xbar);
#ifndef NO_LRU
        lru_apply(*kargs(), l, panel);
#endif
#ifndef NO_S5
        s5_pass<2>(*kargs(), lds, l, panel);
#endif
        __syncthreads();
#ifndef NO_GLA
        gla_pass<2>(*kargs(), lds, l, panel);
#endif
#if REP_MIX
        __syncthreads(); lru_apply(*kargs(), l, panel); s5_pass<2>(*kargs(), lds, l, panel); __syncthreads(); gla_pass<2>(*kargs(), lds, l, panel);
#endif
#if REP_GLA
        __syncthreads(); gla_pass<2>(*kargs(), lds, l, panel);
#endif
#if REP_S5
        __syncthreads(); s5_pass<2>(*kargs(), lds, l, panel); __syncthreads();
#endif
        block_fence();
        {
            PHASE_PTRS();
            pg8::Gemm g{(const bf16_t*)(PB + P_YS5), (const bf16_t*)(ws + WS_WGLU) + (size_t)l * 256 * 256, 256}; pg8::PanelOrder S{1};
            pg8::EpiGlu E{(const bf16_t*)(PB + P_YS5), 256, (bf16_t*)(PB + P_MIX), DM};
#ifndef NO_G2
            pg8::gemm_phase(lds, g, S, E);
#endif
        }
        block_fence();
        {
            PHASE_PTRS();
            pg8::Gemm g{(const bf16_t*)(PB + P_MIX), (const bf16_t*)(ws + WS_WOUT) + (size_t)l * DM * DM, DM}; pg8::PanelOrder S{DM / 256};
            pg8::EpiRes E{HBp, DM, ALPHA};
#ifndef NO_G3
            pg8::gemm_phase(lds, g, S, E);
#endif
        }
        block_fence();
        { PHASE_PTRS(); ln_panel_b(HBp, nullptr, ka->in[24] + l * DM, ka->in[25] + l * DM); }
        block_fence();
        {
            PHASE_PTRS();
            pg8::Gemm g{HBp, (const bf16_t*)(ws + WS_W1) + (size_t)l * DFF * DM, DM}; pg8::PanelOrder S{DFF / 256};
            pg8::EpiBf16<1> E{(bf16_t*)(PB + P_HID), DFF};
#ifndef NO_G4
            pg8::gemm_phase(lds, g, S, E);
#if REP_GEMM
            block_fence(); pg8::gemm_phase(lds, g, S, E);
#endif
#endif
        }
        block_fence();
        {
            PHASE_PTRS();
            pg8::Gemm g{(const bf16_t*)(PB + P_HID), (const bf16_t*)(ws + WS_W2) + (size_t)l * DM * DFF, DFF}; pg8::PanelOrder S{DM / 256};
            pg8::EpiRes E{HBp, DM, ALPHA};
#ifndef NO_G5
            pg8::gemm_phase(lds, g, S, E);
#endif
        }
        block_fence();
        { PHASE_PTRS(); ln_panel_b(HBp, (l + 1 == NLAYER) ? Hp : nullptr, ka->in[28] + l * DM, ka->in[29] + l * DM); }
        block_fence();
    }
}

extern "C" void kernel_launch(void* const* d_in, const int* in_sizes, int n_in, void* d_out, int out_size, void* d_ws, size_t ws_size, hipStream_t stream) {
    static int ready = 0;
    if (ready == 0) {
        if (n_in != 30 || in_sizes[0] != M_TOK * DM || out_size != M_TOK * DM || ws_size < WS_END) {
            fprintf(stderr, "kernel_launch: unexpected shapes (n_in %d, in0 %d, out %d, ws %zu)\n", n_in, n_in > 0 ? in_sizes[0] : -1, out_size, ws_size); ready = -1; return; }
        if (hipFuncSetAttribute((const void*)fwd_megakernel, hipFuncAttributeMaxDynamicSharedMemorySize, LDS_BYTES) != hipSuccess) { fprintf(stderr, "kernel_launch: hipFuncSetAttribute failed\n"); ready = -1; return; }
        int dev = 0, cus = 0, per_cu = 0;
        hipGetDevice(&dev); hipDeviceGetAttribute(&cus, hipDeviceAttributeMultiprocessorCount, dev);
        hipOccupancyMaxActiveBlocksPerMultiprocessor(&per_cu, (const void*)fwd_megakernel, 512, LDS_BYTES);
        if (cus * per_cu < NPANEL) fprintf(stderr, "kernel_launch: note: %d CUs x %d blocks/CU < %d workgroups\n", cus, per_cu, NPANEL);
        (void)hipGetLastError();
        ready = 1;
    }
    if (ready < 0) return;
    if (hipMemsetAsync(d_ws, 0, 16384, stream) != hipSuccess) { fprintf(stderr, "kernel_launch: hipMemsetAsync failed\n"); return; }
    Args a{};
    for (int i = 0; i < 30; ++i) a.in[i] = (const float*)d_in[i];
    a.out = (float*)d_out; a.ws = (unsigned char*)d_ws;
    void* args[] = {&a};
    hipError_t e = hipLaunchCooperativeKernel((const void*)fwd_megakernel, dim3(NPANEL), dim3(512), args, LDS_BYTES, stream);
    if (e != hipSuccess) fprintf(stderr, "kernel_launch: cooperative launch failed: %s\n", hipGetErrorString(e));
}
```

```cpp
#include <hip/hip_runtime.h>
#include <hip/hip_cooperative_groups.h>
#include <cstdio>
#include <cstdint>
namespace cg = cooperative_groups;
#ifndef REP_GEMM
#define REP_GEMM 0
#endif
#ifndef REP_GLA
#define REP_GLA 0
#endif
#ifndef REP_S5
#define REP_S5 0
#endif
#ifndef REP_MIX
#define REP_MIX 0
#endif

#define LAS __attribute__((address_space(3)))
typedef unsigned short bf16_t;
typedef short bf16x8 __attribute__((ext_vector_type(8)));
typedef float f32x4 __attribute__((ext_vector_type(4)));
typedef float f32x2 __attribute__((ext_vector_type(2)));
typedef unsigned u32x4 __attribute__((ext_vector_type(4)));
typedef unsigned u32x2 __attribute__((ext_vector_type(2)));

namespace pg8 {
constexpr int BM = 256, BK = 64, HALF = 128, HTB = HALF * BK * 2, STAGE_BYTES = 8 * HTB;
__host__ __device__ __forceinline__ int lds_byte(int r, int c) { const int st = (r >> 4) * 2 + (c >> 5), rr = r & 15, cc = c & 31, ob = rr * 64 + cc * 2; return st * 1024 + (ob ^ (((ob >> 9) & 1) << 5)); }
__host__ __device__ __forceinline__ void stage_rc(int b, int& R, int& C) { const int st = b / 1024, sb = b % 1024, swz = sb ^ (((sb >> 9) & 1) << 5); R = (st >> 1) * 16 + swz / 64; C = (st & 1) * 32 + (swz % 64) / 2; }
__host__ __device__ __forceinline__ int perm32(int rho) { const int n = rho >> 4, i = rho & 15; return 8 * (i >> 2) + 4 * n + (i & 3); }
struct Unit { int pm, pn; };
struct Gemm { const bf16_t* A; const bf16_t* Bt; int K; };
struct PanelOrder {
    int nN;
    __device__ __forceinline__ bool next(int i, Unit& u) const { u.pm = 0; u.pn = i; return i < nN; }
    __device__ __forceinline__ void a_ready(const Unit&) const {}
    __device__ __forceinline__ void done(const Unit&) const {}
};
__device__ __forceinline__ float bflo_(unsigned w) { return __uint_as_float(w << 16); }
__device__ __forceinline__ float bfhi_(unsigned w) { return __uint_as_float(w & 0xffff0000u); }
__device__ __forceinline__ unsigned cvt_pk_bf16(float lo, float hi) { unsigned r; asm volatile("v_cvt_pk_bf16_f32 %0, %1, %2" : "=v"(r) : "v"(lo), "v"(hi)); return r; }

template <class Epi, class Sched>
__device__ __forceinline__ void gemm_phase(LAS unsigned char* lds, const Gemm g, const Sched& S, const Epi& E) {
    int tid = threadIdx.x; asm volatile("" : "+v"(tid));
    const int wid = __builtin_amdgcn_readfirstlane(tid >> 6), lane = tid & 63, wr = wid >> 2, wc = wid & 3, fr = lane & 15, fq = lane >> 4;
    int K = g.K; asm volatile("" : "+s"(K));
    const int nt = K / BK;
    unsigned voffA[2], voffB[2];
#pragma unroll
    for (int i = 0; i < 2; ++i) { int R, C; stage_rc(tid * 16 + i * 8192, R, C); const int Rb = Epi::PERM ? ((R & ~31) + perm32(R & 31)) : R;
        voffA[i] = (unsigned)(R * K + C) * 2u; voffB[i] = (unsigned)(Rb * K + C) * 2u; }
    const size_t kstep = (size_t)(BK * 2);
    const size_t hstep = (size_t)HALF * K * 2;
    const size_t tstep = 2 * hstep;
    const unsigned ldsw = (unsigned)wid * 1024u;
    const int aoff = lds_byte(wr * 64 + fr, fq * 8), boff = lds_byte(wc * 32 + fr, fq * 8);
#define PG8_SA(b, h) (((b) * 2 + (h)) * HTB)
#define PG8_SB(b, h) ((4 + (b) * 2 + (h)) * HTB)
#define PG8_STAGE(bufoff, gbase, voff) do { _Pragma("unroll") for (int _i = 0; _i < 2; ++_i) \
        __builtin_amdgcn_global_load_lds((const unsigned*)((const char*)(gbase) + (voff)[_i]), (LAS unsigned*)(lds + (bufoff) + ldsw + _i * 8192), 16, 0, 0); } while (0)
#define PG8_LDA(dst, b, h) do { _Pragma("unroll") for (int m = 0; m < 4; ++m) _Pragma("unroll") for (int k = 0; k < 2; ++k) dst[m][k] = *(const LAS bf16x8*)(lds + PG8_SA(b, h) + aoff + m * 2048 + k * 1024); } while (0)
#define PG8_LDB(dst, b, h) do { _Pragma("unroll") for (int n = 0; n < 2; ++n) _Pragma("unroll") for (int k = 0; k < 2; ++k) dst[n][k] = *(const LAS bf16x8*)(lds + PG8_SB(b, h) + boff + n * 2048 + k * 1024); } while (0)
#define PG8_MMA(ai, bj, At, Bt) do { __builtin_amdgcn_s_setprio(1); _Pragma("unroll") for (int m = 0; m < 4; ++m) _Pragma("unroll") for (int n = 0; n < 2; ++n) _Pragma("unroll") for (int k = 0; k < 2; ++k) \
        acc[ai][bj][m][n] = __builtin_amdgcn_mfma_f32_16x16x32_bf16(Bt[n][k], At[m][k], acc[ai][bj][m][n], 0, 0, 0); __builtin_amdgcn_s_setprio(0); } while (0)
#define PG8_WAIT_V(n) asm volatile("s_waitcnt vmcnt(" #n ")" ::: "memory")
#define PG8_WAIT_L(n) asm volatile("s_waitcnt lgkmcnt(" #n ")" ::: "memory")
#define PG8_BAR __builtin_amdgcn_s_barrier()
#define PG8_SCHED __builtin_amdgcn_sched_barrier(0)
    Unit cur, nxt; int ui = 0;
    if (!S.next(0, cur)) return;
    f32x4 acc[2][2][4][2];
#pragma unroll
    for (int a = 0; a < 2; ++a)
#pragma unroll
        for (int b = 0; b < 2; ++b)
#pragma unroll
            for (int m = 0; m < 4; ++m)
#pragma unroll
                for (int n = 0; n < 2; ++n) acc[a][b][m][n] = (f32x4){0.f, 0.f, 0.f, 0.f};
    bf16x8 At[4][2], B0[2][2], B1[2][2];
    const char* cA = (const char*)g.A + (size_t)cur.pm * tstep; const char* cB = (const char*)g.Bt + (size_t)cur.pn * tstep;
    S.a_ready(cur);
    PG8_STAGE(PG8_SB(0, 0), cB, voffB); PG8_STAGE(PG8_SB(0, 1), cB + hstep, voffB); PG8_STAGE(PG8_SA(0, 0), cA, voffA); PG8_STAGE(PG8_SA(0, 1), cA + hstep, voffA);
    if (wr == 1) PG8_BAR;
    PG8_WAIT_V(2); PG8_BAR;
    PG8_STAGE(PG8_SB(1, 0), cB + kstep, voffB); PG8_STAGE(PG8_SA(1, 0), cA + kstep, voffA); PG8_STAGE(PG8_SB(1, 1), cB + hstep + kstep, voffB);
    PG8_WAIT_V(6); PG8_BAR;
    for (;;) {
        const bool has_next = S.next(ui + 1, nxt);
        const char* nA = has_next ? (const char*)g.A + (size_t)nxt.pm * tstep : cA; const char* nB = has_next ? (const char*)g.Bt + (size_t)nxt.pn * tstep : cB;
        for (int t = 0; t < nt; t += 2) {
            const bool last = (t == nt - 2);
            const char* a1 = cA + (size_t)(t + 1) * kstep;
            const char* a2 = last ? nA : cA + (size_t)(t + 2) * kstep; const char* b2 = last ? nB : cB + (size_t)(t + 2) * kstep;
            const char* a3 = a2 + kstep; const char* b3 = b2 + kstep;
            if (last && has_next) S.a_ready(nxt);
            PG8_LDB(B0, 0, 0); PG8_LDB(B1, 0, 1); PG8_SCHED; PG8_LDA(At, 0, 0); PG8_STAGE(PG8_SA(1, 1), a1 + hstep, voffA);
            PG8_WAIT_V(8); PG8_WAIT_L(0); PG8_BAR; PG8_MMA(0, 0, At, B0); PG8_MMA(0, 1, At, B1); PG8_BAR; PG8_SCHED;
            PG8_LDA(At, 0, 1); PG8_STAGE(PG8_SB(0, 0), b2, voffB); PG8_STAGE(PG8_SB(0, 1), b2 + hstep, voffB); PG8_STAGE(PG8_SA(0, 0), a2, voffA);
            PG8_WAIT_V(8); PG8_WAIT_L(0); PG8_BAR; PG8_MMA(1, 0, At, B0); PG8_MMA(1, 1, At, B1); PG8_BAR; PG8_SCHED;
            PG8_LDB(B0, 1, 0); PG8_LDB(B1, 1, 1); PG8_SCHED; PG8_LDA(At, 1, 0); PG8_STAGE(PG8_SA(0, 1), a2 + hstep, voffA);
            PG8_WAIT_V(8); PG8_WAIT_L(0); PG8_BAR; PG8_MMA(0, 0, At, B0); PG8_MMA(0, 1, At, B1); PG8_BAR; PG8_SCHED;
            PG8_LDA(At, 1, 1); PG8_STAGE(PG8_SB(1, 0), b3, voffB); PG8_STAGE(PG8_SB(1, 1), b3 + hstep, voffB); PG8_STAGE(PG8_SA(1, 0), a3, voffA);
            PG8_WAIT_V(8); PG8_WAIT_L(0); PG8_BAR; PG8_MMA(1, 0, At, B0); PG8_MMA(1, 1, At, B1); PG8_BAR; PG8_SCHED;
        }
        if (wr == 0) PG8_BAR;
        E(acc, cur, wr, wc, fr, fq); S.done(cur);
        if (!has_next) break;
#pragma unroll
        for (int a = 0; a < 2; ++a)
#pragma unroll
            for (int b = 0; b < 2; ++b)
#pragma unroll
                for (int m = 0; m < 4; ++m)
#pragma unroll
                    for (int n = 0; n < 2; ++n) acc[a][b][m][n] = (f32x4){0.f, 0.f, 0.f, 0.f};
        cur = nxt; cA = nA; cB = nB; ++ui;
        if (wr == 1) PG8_BAR;
    }
    PG8_WAIT_V(0);
    PG8_BAR;
#undef PG8_SA
#undef PG8_SB
#undef PG8_STAGE
#undef PG8_LDA
#undef PG8_LDB
#undef PG8_MMA
#undef PG8_WAIT_V
#undef PG8_WAIT_L
#undef PG8_BAR
#undef PG8_SCHED
}

#define PG8_OPQ(p) asm volatile("" : "+v"(p))
template <int ACT  > struct EpiBf16 {
    static constexpr bool PERM = true;
    bf16_t* O; int ldc;
    __device__ __forceinline__ void operator()(const f32x4 (&acc)[2][2][4][2], const Unit& u, int wr, int wc, int fr, int fq) const {
        char* p = (char*)(O + (size_t)(wr * 64 + fr) * ldc + u.pn * BM + wc * 32 + 8 * fq);
        const size_t step = (size_t)16 * ldc * 2;
#pragma unroll
        for (int ai = 0; ai < 2; ++ai) {
#pragma unroll
            for (int m = 0; m < 4; ++m) {
                PG8_OPQ(p);
#pragma unroll
                for (int bj = 0; bj < 2; ++bj) { f32x4 v0 = acc[ai][bj][m][0], v1 = acc[ai][bj][m][1];
                    if (ACT == 1) {
#pragma unroll
                        for (int j = 0; j < 4; ++j) { const float a0 = fmaxf(v0[j], 0.f), a1 = fmaxf(v1[j], 0.f); v0[j] = a0 * a0; v1[j] = a1 * a1; } }
                    u32x4 w; w.x = cvt_pk_bf16(v0[0], v0[1]); w.y = cvt_pk_bf16(v0[2], v0[3]); w.z = cvt_pk_bf16(v1[0], v1[1]); w.w = cvt_pk_bf16(v1[2], v1[3]);
                    *(u32x4*)(p + bj * HALF * 2) = w; }
                p += step;
            }
            p += 4 * step;
        }
    }
};
struct EpiGlu {
    static constexpr bool PERM = true;
    const bf16_t* Y; int ldy; bf16_t* O; int ldc;
    __device__ __forceinline__ void operator()(const f32x4 (&acc)[2][2][4][2], const Unit& u, int wr, int wc, int fr, int fq) const {
        const int col0 = u.pn * BM + wc * 32 + 8 * fq;
        const char* py = (const char*)(Y + (size_t)(wr * 64 + fr) * ldy + col0);
        char* po = (char*)(O + (size_t)(wr * 64 + fr) * ldc + col0);
        const size_t sy = (size_t)16 * ldy * 2, so = (size_t)16 * ldc * 2;
#pragma unroll
        for (int ai = 0; ai < 2; ++ai) {
#pragma unroll
            for (int m = 0; m < 4; ++m) {
                PG8_OPQ(py); PG8_OPQ(po); asm volatile("" ::: "memory");
#pragma unroll
                for (int bj = 0; bj < 2; ++bj) { const f32x4 v0 = acc[ai][bj][m][0], v1 = acc[ai][bj][m][1];
                    const u32x4 yv = *(const u32x4*)(py + bj * HALF * 2);
                    u32x4 w;
                    w.x = cvt_pk_bf16(bflo_(yv.x) * __builtin_amdgcn_rcpf(1.f + __expf(-v0[0])), bfhi_(yv.x) * __builtin_amdgcn_rcpf(1.f + __expf(-v0[1])));
                    w.y = cvt_pk_bf16(bflo_(yv.y) * __builtin_amdgcn_rcpf(1.f + __expf(-v0[2])), bfhi_(yv.y) * __builtin_amdgcn_rcpf(1.f + __expf(-v0[3])));
                    w.z = cvt_pk_bf16(bflo_(yv.z) * __builtin_amdgcn_rcpf(1.f + __expf(-v1[0])), bfhi_(yv.z) * __builtin_amdgcn_rcpf(1.f + __expf(-v1[1])));
                    w.w = cvt_pk_bf16(bflo_(yv.w) * __builtin_amdgcn_rcpf(1.f + __expf(-v1[2])), bfhi_(yv.w) * __builtin_amdgcn_rcpf(1.f + __expf(-v1[3])));
                    *(u32x4*)(po + bj * HALF * 2) = w; }
                py += sy; po += so;
            }
            py += 4 * sy; po += 4 * so;
        }
    }
};
struct EpiRes {
    static constexpr bool PERM = true;
    bf16_t* HB; int ldc; float alpha;
    __device__ __forceinline__ void operator()(const f32x4 (&acc)[2][2][4][2], const Unit& u, int wr, int wc, int fr, int fq) const {
        char* p = (char*)(HB + (size_t)(wr * 64 + fr) * ldc + u.pn * BM + wc * 32 + 8 * fq);
        const size_t step = (size_t)16 * ldc * 2;
#pragma unroll
        for (int ai = 0; ai < 2; ++ai) {
#pragma unroll
            for (int m = 0; m < 4; ++m) {
                PG8_OPQ(p);
#pragma unroll
                for (int bj = 0; bj < 2; ++bj) { const f32x4 v0 = acc[ai][bj][m][0], v1 = acc[ai][bj][m][1];
                    const u32x4 h = *(const u32x4*)(p + bj * HALF * 2);
                    u32x4 w;
                    w.x = cvt_pk_bf16(bflo_(h.x) * alpha + v0[0], bfhi_(h.x) * alpha + v0[1]); w.y = cvt_pk_bf16(bflo_(h.y) * alpha + v0[2], bfhi_(h.y) * alpha + v0[3]);
                    w.z = cvt_pk_bf16(bflo_(h.z) * alpha + v1[0], bfhi_(h.z) * alpha + v1[1]); w.w = cvt_pk_bf16(bflo_(h.w) * alpha + v1[2], bfhi_(h.w) * alpha + v1[3]);
                    *(u32x4*)(p + bj * HALF * 2) = w; }
                p += step;
            }
            p += 4 * step;
        }
    }
};
}

constexpr int M_TOK = 65536, DM = 1024, DIN = 2320, DINP = 2560, DFF = 4096, NPANEL = 256, NLAYER = 2;
constexpr int C_S5U = 0, C_Q = 256, C_K = 512, C_V = 768, C_R = 1280, C_LX = 1792, C_LG = 2048, C_GZ = 2304, NZ_MAIN = 2304;
constexpr int ZROWB = DINP * 2;
constexpr float ALPHA = 1.4142135623730951f;
constexpr float LN_EPS = 1e-5f;
constexpr size_t MiB = 1u << 20;
constexpr size_t WS_WIN = 2 * MiB, WS_WOUT = 12 * MiB, WS_W1 = 16 * MiB, WS_W2 = 32 * MiB, WS_WGLU = 48 * MiB;
constexpr size_t WS_LRUW = 48 * MiB + 512 * 1024, WS_S5A = 49 * MiB, WS_S5M = 50 * MiB, WS_S5W = 56 * MiB;
constexpr size_t WS_LRUA = 58 * MiB, WS_LRUB = 58 * MiB + 256 * 1024, WS_S5H = 59 * MiB, WS_GLAD = 61 * MiB, WS_GLAS = 64 * MiB;
constexpr size_t WS_HB = 96 * MiB, WS_PANEL = 224 * MiB, PANEL_BYTES = 2 * MiB;
constexpr size_t WS_LRUAB = 736 * MiB, WS_LRUC = 800 * MiB, WS_END = 808 * MiB;
constexpr size_t P_Z = 0, P_MIX = 1310720, P_YS5 = 1310720 + 524288, P_HID = 0;
constexpr int LDS_BYTES = 147456;
constexpr int LDS_TA = 131072, LDS_TB = 131072 + 2048, LDS_XB = 131072 + 8192;

struct Args { const float* in[30]; float* out; unsigned char* ws; };
typedef const Args __attribute__((address_space(4))) CArgs;
__device__ __forceinline__ CArgs* kargs() { CArgs* p = (CArgs*)__builtin_amdgcn_kernarg_segment_ptr(); asm volatile("" : "+s"(p)); return p; }

__device__ __forceinline__ unsigned pk2(float lo, float hi) { unsigned r; asm("v_cvt_pk_bf16_f32 %0, %1, %2" : "=v"(r) : "v"(lo), "v"(hi)); return r; }
__device__ __forceinline__ unsigned f2bf(float f) { return pk2(f, f) & 0xffffu; }
__device__ __forceinline__ float bflo(unsigned w) { return __uint_as_float(w << 16); }
__device__ __forceinline__ float bfhi(unsigned w) { return __uint_as_float(w & 0xffff0000u); }
__device__ __forceinline__ float bf1(bf16_t v) { return __uint_as_float(((unsigned)v) << 16); }
__device__ __forceinline__ float sigmoidf_(float x) { return __builtin_amdgcn_rcpf(1.f + __expf(-x)); }
__device__ __forceinline__ float gelu_tanh(float x) { const float u = 0.7978845608028654f * (x + 0.044715f * x * x * x); return x * __builtin_amdgcn_rcpf(1.f + __expf(-2.f * u)); }
__device__ __forceinline__ void lds_fence() { asm volatile("s_waitcnt lgkmcnt(0)" ::: "memory"); }
__device__ __forceinline__ void block_fence() { __builtin_amdgcn_fence(__ATOMIC_RELEASE, "workgroup"); __syncthreads(); __builtin_amdgcn_fence(__ATOMIC_ACQUIRE, "workgroup"); }
__device__ __forceinline__ float wave_sum(float v) {
#pragma unroll
    for (int o = 1; o < 64; o <<= 1) v += __shfl_xor(v, o);
    return v;
}
__device__ __forceinline__ f32x4 mfma16(bf16x8 a, bf16x8 b, f32x4 c) { return __builtin_amdgcn_mfma_f32_16x16x32_bf16(a, b, c, 0, 0, 0); }

template <bool WIN_PERM = false  >
__device__ __forceinline__ void transpose_item(const float* W, int K, int N, int Npad, bf16_t* WT, LAS float* scr, int item, int lane) {
    const int nblk = Npad / 32, kb = item / nblk, nb = item % nblk, k0 = 64 * kb, n0 = 32 * nb;
    const int nn = n0 + (lane & 31);
    const int sc = !WIN_PERM ? nn : (nn < 1792 ? nn : (nn < 2304 ? nn + 16 : nn - 512));
#pragma unroll 8
    for (int i = 0; i < 32; ++i) { const int kk = 2 * i + (lane >> 5); scr[kk * 33 + (lane & 31)] = (nn < N) ? W[(size_t)(k0 + kk) * N + sc] : 0.f; }
    lds_fence();
    const int c = lane & 7;
#pragma unroll
    for (int j = 0; j < 4; ++j) { const int n = (lane >> 3) + 8 * j; const LAS float* s = scr + (8 * c) * 33 + n;
        u32x4 o; o.x = pk2(s[0 * 33], s[1 * 33]); o.y = pk2(s[2 * 33], s[3 * 33]); o.z = pk2(s[4 * 33], s[5 * 33]); o.w = pk2(s[6 * 33], s[7 * 33]);
        *(u32x4*)(WT + (size_t)(n0 + n) * K + k0 + 8 * c) = o; }
    lds_fence();
}
__device__ __forceinline__ void s5_pow(float lrdt, float rev1, float n, float& pr, float& pi) {
    const float mag = __expf(n * lrdt);
    const float r = n * rev1, rr = __builtin_fmaf(n, rev1, -r);
    const float fr_ = (r - rintf(r)) + rr;
    pr = mag * __builtin_amdgcn_cosf(fr_); pi = mag * __builtin_amdgcn_sinf(fr_);
}
struct S5Lane { float lrdt, rev1, fre, fim; };
__device__ __forceinline__ S5Lane s5_lane(CArgs& a, int l, int g, int p) {
    S5Lane s;
    const float dt = expf(a.in[6][l * 16 + g]);
    const float lr = fminf(a.in[4][(l * 16 + g) * 64 + p], -1e-4f), li = a.in[5][(l * 16 + g) * 64 + p];
    s.lrdt = lr * dt; const float ang = li * dt; s.rev1 = ang * 0.15915494309189535f;
    float ar, ai; s5_pow(s.lrdt, s.rev1, 1.f, ar, ai);
    const float den = lr * lr + li * li;
    s.fre = ((ar - 1.f) * lr + ai * li) / den; s.fim = (ai * lr - (ar - 1.f) * li) / den;
    return s;
}
__device__ __forceinline__ void s5_prep_k(CArgs& a, unsigned char* ws, LAS float* scr, int l, int g, int d, int lane) {
    const int p = lane; const S5Lane s = s5_lane(a, l, g, p);
    float pr, pi; s5_pow(s.lrdt, s.rev1, (float)d, pr, pi);
    const float* bre = a.in[7] + ((size_t)(l * 16 + g) * 64 + p) * 16; const float* bim = a.in[8] + ((size_t)(l * 16 + g) * 64 + p) * 16;
    const float* cre = a.in[9] + (size_t)(l * 16 + g) * 16 * 64 + p; const float* cim = a.in[10] + (size_t)(l * 16 + g) * 16 * 64 + p;
    for (int c = 0; c < 16; ++c) {
        const float cr = cre[c * 64], ci = cim[c * 64];
        scr[(0 * 16 + c) * 65 + p] = cr * pr - ci * pi; scr[(1 * 16 + c) * 65 + p] = cr * pi + ci * pr;
        const float br = bre[c], bi = bim[c];
        scr[(2 * 16 + c) * 65 + p] = s.fre * br - s.fim * bi; scr[(3 * 16 + c) * 65 + p] = s.fre * bi + s.fim * br;
    }
    lds_fence();
    bf16_t* Mg = (bf16_t*)(ws + WS_S5M) + (size_t)(l * 16 + g) * 64 * 192;
    for (int q = 0; q < 4; ++q) {
        const int idx = lane + 64 * q, co = idx >> 4, ci = idx & 15;
        float v = 0.f;
        for (int pp = 0; pp < 64; ++pp) v += scr[(0 * 16 + co) * 65 + pp] * scr[(2 * 16 + ci) * 65 + pp] - scr[(1 * 16 + co) * 65 + pp] * scr[(3 * 16 + ci) * 65 + pp];
        const bf16_t vb = (bf16_t)f2bf(v);
        for (int to = d; to < 4; ++to) {
            Mg[(size_t)(to * 16 + co) * 192 + (to - d) * 16 + ci] = vb;
            if (d > 0) Mg[(size_t)((to - d) * 16 + co) * 192 + to * 16 + ci] = 0;
        }
    }
    lds_fence();
}
__device__ __forceinline__ void s5_prep_vw(CArgs& a, unsigned char* ws, int l, int g, int lane) {
    const int p = lane; const S5Lane s = s5_lane(a, l, g, p);
    float* A = (float*)(ws + WS_S5A) + ((size_t)(l * 16 + g) * 64 + p) * 4;
    { float r4, i4, r256, i256; s5_pow(s.lrdt, s.rev1, 4.f, r4, i4); s5_pow(s.lrdt, s.rev1, 256.f, r256, i256); A[0] = r4; A[1] = i4; A[2] = r256; A[3] = i256; }
    const float* bre = a.in[7] + ((size_t)(l * 16 + g) * 64 + p) * 16; const float* bim = a.in[8] + ((size_t)(l * 16 + g) * 64 + p) * 16;
    const float* cre = a.in[9] + (size_t)(l * 16 + g) * 16 * 64 + p; const float* cim = a.in[10] + (size_t)(l * 16 + g) * 16 * 64 + p;
    bf16_t* Wg = (bf16_t*)(ws + WS_S5W) + (size_t)(l * 16 + g) * 128 * 64;
    bf16_t* Mg = (bf16_t*)(ws + WS_S5M) + (size_t)(l * 16 + g) * 64 * 192;
    float bbr[16], bbi[16], cr[16], ci[16];
#pragma unroll
    for (int c = 0; c < 16; ++c) { const float br = bre[c], bi = bim[c]; bbr[c] = s.fre * br - s.fim * bi; bbi[c] = s.fre * bi + s.fim * br; cr[c] = cre[c * 64]; ci[c] = cim[c * 64]; }
#pragma unroll 1
    for (int t = 0; t < 4; ++t) {
        float pr, pi; s5_pow(s.lrdt, s.rev1, (float)(3 - t), pr, pi);
        float qr, qi; s5_pow(s.lrdt, s.rev1, (float)(t + 1), qr, qi);
#pragma unroll
        for (int c = 0; c < 16; c += 2) {
            *(unsigned*)(Wg + (size_t)(2 * p) * 64 + t * 16 + c) = pk2(pr * bbr[c] - pi * bbi[c], pr * bbr[c + 1] - pi * bbi[c + 1]);
            *(unsigned*)(Wg + (size_t)(2 * p + 1) * 64 + t * 16 + c) = pk2(pr * bbi[c] + pi * bbr[c], pr * bbi[c + 1] + pi * bbr[c + 1]);
        }
#pragma unroll
        for (int c = 0; c < 16; ++c) {
            const float vr = cr[c] * qr - ci[c] * qi, vi = cr[c] * qi + ci[c] * qr;
            *(unsigned*)(Mg + (size_t)(t * 16 + c) * 192 + 64 + 2 * p) = pk2(vr, -vi);
        }
    }
}
__device__ __forceinline__ void ln_panel(const float* src, float* dst, bf16_t* dstb, const float* gam, const float* bet, LAS f32x2* T) {
    int tid_ = threadIdx.x; asm volatile("" : "+v"(tid_));
    const int lane = tid_ & 63, wave = __builtin_amdgcn_readfirstlane(tid_ >> 6);
    constexpr int NB = 2;
    f32x4 cur[NB][4], nxt[NB][4];
    const int r0 = wave * 32;
#pragma unroll
    for (int b = 0; b < NB; ++b)
#pragma unroll
        for (int j = 0; j < 4; ++j) cur[b][j] = ((const f32x4*)(src + (size_t)(r0 + b) * DM))[lane + 64 * j];
    f32x4 gv[4], bv[4];
#pragma unroll
    for (int j = 0; j < 4; ++j) { gv[j] = ((const f32x4*)gam)[lane + 64 * j]; bv[j] = ((const f32x4*)bet)[lane + 64 * j]; }
    for (int it = 0; it < 32 / NB; ++it) {
        const int r = r0 + it * NB;
        if (it + 1 < 32 / NB) {
#pragma unroll
            for (int b = 0; b < NB; ++b)
#pragma unroll
                for (int j = 0; j < 4; ++j) nxt[b][j] = ((const f32x4*)(src + (size_t)(r + NB + b) * DM))[lane + 64 * j];
        }
        float s[NB], s2[NB];
#pragma unroll
        for (int b = 0; b < NB; ++b) { s[b] = 0.f;
#pragma unroll
            for (int j = 0; j < 4; ++j) s[b] += (cur[b][j].x + cur[b][j].y) + (cur[b][j].z + cur[b][j].w); }
#pragma unroll
        for (int o = 1; o < 64; o <<= 1)
#pragma unroll
            for (int b = 0; b < NB; ++b) s[b] += __shfl_xor(s[b], o);
#pragma unroll
        for (int b = 0; b < NB; ++b) { const float mean = s[b] * (1.f / DM); s2[b] = 0.f;
#pragma unroll
            for (int j = 0; j < 4; ++j) { cur[b][j] = cur[b][j] - mean; s2[b] += (cur[b][j].x * cur[b][j].x + cur[b][j].y * cur[b][j].y) + (cur[b][j].z * cur[b][j].z + cur[b][j].w * cur[b][j].w); } }
#pragma unroll
        for (int o = 1; o < 64; o <<= 1)
#pragma unroll
            for (int b = 0; b < NB; ++b) s2[b] += __shfl_xor(s2[b], o);
#pragma unroll
        for (int b = 0; b < NB; ++b) {
            const float rstd = 1.f / sqrtf(s2[b] * (1.f / DM) + LN_EPS);
            if (T && lane == 0) T[r + b] = (f32x2){s[b] * (1.f / DM), rstd};
#pragma unroll
            for (int j = 0; j < 4; ++j) {
                const f32x4 o = cur[b][j] * rstd * gv[j] + bv[j];
                if (dst) ((f32x4*)(dst + (size_t)(r + b) * DM))[lane + 64 * j] = o;
                if (dstb) { u32x2 w; w.x = pk2(o.x, o.y); w.y = pk2(o.z, o.w); ((u32x2*)(dstb + (size_t)(r + b) * DM))[lane + 64 * j] = w; }
            }
        }
#pragma unroll
        for (int b = 0; b < NB; ++b)
#pragma unroll
            for (int j = 0; j < 4; ++j) cur[b][j] = nxt[b][j];
    }
}

__device__ __forceinline__ void ln_panel_b(bf16_t* hb, float* outf, const float* gam, const float* bet) {
    int tid_ = threadIdx.x; asm volatile("" : "+v"(tid_));
    const int lane = tid_ & 63, wave = __builtin_amdgcn_readfirstlane(tid_ >> 6);
    constexpr int NB = 2;
    u32x4 nxt[NB][2];
    const int r0 = wave * 32;
#pragma unroll
    for (int b = 0; b < NB; ++b)
#pragma unroll
        for (int j = 0; j < 2; ++j) nxt[b][j] = ((const u32x4*)(hb + (size_t)(r0 + b) * DM))[lane + 64 * j];
    f32x4 gv[2][2], bv[2][2];
#pragma unroll
    for (int j = 0; j < 2; ++j)
#pragma unroll
        for (int q = 0; q < 2; ++q) { gv[j][q] = *(const f32x4*)(gam + 512 * j + 8 * lane + 4 * q); bv[j][q] = *(const f32x4*)(bet + 512 * j + 8 * lane + 4 * q); }
    for (int it = 0; it < 32 / NB; ++it) {
        const int r = r0 + it * NB;
        float v[NB][16];
#pragma unroll
        for (int b = 0; b < NB; ++b)
#pragma unroll
            for (int j = 0; j < 2; ++j)
#pragma unroll
                for (int k = 0; k < 4; ++k) { v[b][8 * j + 2 * k] = bflo(nxt[b][j][k]); v[b][8 * j + 2 * k + 1] = bfhi(nxt[b][j][k]); }
        if (it + 1 < 32 / NB) {
#pragma unroll
            for (int b = 0; b < NB; ++b)
#pragma unroll
                for (int j = 0; j < 2; ++j) nxt[b][j] = ((const u32x4*)(hb + (size_t)(r + NB + b) * DM))[lane + 64 * j];
        }
        float s[NB], s2[NB];
#pragma unroll
        for (int b = 0; b < NB; ++b) { s[b] = 0.f;
#pragma unroll
            for (int k = 0; k < 16; ++k) s[b] += v[b][k]; }
#pragma unroll
        for (int o = 1; o < 64; o <<= 1)
#pragma unroll
            for (int b = 0; b < NB; ++b) s[b] += __shfl_xor(s[b], o);
#pragma unroll
        for (int b = 0; b < NB; ++b) { const float mean = s[b] * (1.f / DM); s2[b] = 0.f;
#pragma unroll
            for (int k = 0; k < 16; ++k) { v[b][k] -= mean; s2[b] += v[b][k] * v[b][k]; } }
#pragma unroll
        for (int o = 1; o < 64; o <<= 1)
#pragma unroll
            for (int b = 0; b < NB; ++b) s2[b] += __shfl_xor(s2[b], o);
#pragma unroll
        for (int b = 0; b < NB; ++b) {
            const float rstd = 1.f / sqrtf(s2[b] * (1.f / DM) + LN_EPS);
#pragma unroll
            for (int j = 0; j < 2; ++j) {
                float o[8];
#pragma unroll
                for (int k = 0; k < 8; ++k) o[k] = v[b][8 * j + k] * rstd * gv[j][k >> 2][k & 3] + bv[j][k >> 2][k & 3];
                if (outf) { f32x4* op = (f32x4*)(outf + (size_t)(r + b) * DM + 512 * j + 8 * lane); op[0] = (f32x4){o[0], o[1], o[2], o[3]}; op[1] = (f32x4){o[4], o[5], o[6], o[7]}; }
                else { u32x4 w; w.x = pk2(o[0], o[1]); w.y = pk2(o[2], o[3]); w.z = pk2(o[4], o[5]); w.w = pk2(o[6], o[7]); ((u32x4*)(hb + (size_t)(r + b) * DM))[lane + 64 * j] = w; }
            }
        }
    }
}

__device__ __forceinline__ void prologue(CArgs& a, LAS unsigned char* lds, int panel, int G) {
    int tid_ = threadIdx.x; asm volatile("" : "+v"(tid_));
    const int lane = tid_ & 63, wave = __builtin_amdgcn_readfirstlane(tid_ >> 6);
    unsigned char* ws = a.ws;
    LAS float* scr = (LAS float*)(lds + wave * 17408);
    const int gw = panel * 8 + wave, NGW = G * 8;
    constexpr int I_IN = (DM / 64) * (DINP / 32), I_OUT = (DM / 64) * (DM / 32), I_1 = (DM / 64) * (DFF / 32), I_2 = (DFF / 64) * (DM / 32), I_G = (256 / 64) * (256 / 32);
    constexpr int I_L = I_IN + I_OUT + I_1 + I_2 + I_G;
    for (int it = gw; it < NLAYER * I_L; it += NGW) {
        const int l = it / I_L; int r = it % I_L;
        if (r < I_IN) { transpose_item<true>(a.in[3] + (size_t)l * DM * DIN, DM, DIN, DINP, (bf16_t*)(ws + WS_WIN) + (size_t)l * DINP * DM, scr, r, lane); continue; } r -= I_IN;
        if (r < I_OUT) { transpose_item(a.in[23] + (size_t)l * DM * DM, DM, DM, DM, (bf16_t*)(ws + WS_WOUT) + (size_t)l * DM * DM, scr, r, lane); continue; } r -= I_OUT;
        if (r < I_1) { transpose_item(a.in[26] + (size_t)l * DM * DFF, DM, DFF, DFF, (bf16_t*)(ws + WS_W1) + (size_t)l * DFF * DM, scr, r, lane); continue; } r -= I_1;
        if (r < I_2) { transpose_item(a.in[27] + (size_t)l * DFF * DM, DFF, DM, DM, (bf16_t*)(ws + WS_W2) + (size_t)l * DM * DFF, scr, r, lane); continue; } r -= I_2;
        transpose_item(a.in[12] + (size_t)l * 256 * 256, 256, 256, 256, (bf16_t*)(ws + WS_WGLU) + (size_t)l * 256 * 256, scr, r, lane);
    }
    for (int it = NGW - 1 - gw; it < NLAYER * 16 * 5; it += NGW) {
        const int l = it / (16 * 5), r = it % (16 * 5), g = r / 5, d = r % 5;
        if (d < 4) s5_prep_k(a, ws, scr, l, g, d, lane); else s5_prep_vw(a, ws, l, g, lane);
    }
    for (int e = gw * 64 + lane; e < NLAYER * 2 * 8 * 1024; e += NGW * 64) {
        const int i = e & 31, j = (e >> 5) & 31, h = (e >> 10) & 7, which = (e >> 13) & 1, l = e >> 14;
        const float* w = a.in[which ? 20 : 18] + (size_t)(l * 8 + h) * 1024;
        ((bf16_t*)(ws + WS_LRUW))[e] = (bf16_t)f2bf(w[i * 32 + j]);
    }
    __syncthreads();
    ln_panel(a.in[0] + (size_t)panel * 256 * DM, nullptr, (bf16_t*)(ws + WS_HB) + (size_t)panel * 256 * DM, a.in[1], a.in[2], nullptr);
}

__device__ __forceinline__ void gz_phase(CArgs& a, int l, int panel) {
    int tid_ = threadIdx.x; asm volatile("" : "+v"(tid_));
    const int lane = tid_ & 63, wave = __builtin_amdgcn_readfirstlane(tid_ >> 6), fr = lane & 15, fq = lane >> 4;
    unsigned char* ws = a.ws;
    const bf16_t* Hb = (const bf16_t*)(ws + WS_HB) + (size_t)panel * 256 * DM + (size_t)(wave * 32 + fr) * DM + 8 * fq;
    const bf16_t* Wt = (const bf16_t*)(ws + WS_WIN) + (size_t)l * DINP * DM + (size_t)(C_GZ + fr) * DM + 8 * fq;
    f32x4 acc0 = (f32x4){0.f, 0.f, 0.f, 0.f}, acc1 = acc0;
#pragma unroll 8
    for (int ks = 0; ks < 32; ++ks) {
        const bf16x8 wf = *(const bf16x8*)(Wt + 32 * ks);
        acc0 = mfma16(wf, *(const bf16x8*)(Hb + 32 * ks), acc0);
        acc1 = mfma16(wf, *(const bf16x8*)(Hb + 16 * DM + 32 * ks), acc1);
    }
    unsigned char* Zp = ws + WS_PANEL + (size_t)panel * PANEL_BYTES + P_Z;
    u32x2 w0, w1; w0.x = pk2(acc0[0], acc0[1]); w0.y = pk2(acc0[2], acc0[3]); w1.x = pk2(acc1[0], acc1[1]); w1.y = pk2(acc1[2], acc1[3]);
    *(u32x2*)(Zp + (size_t)(wave * 32 + fr) * ZROWB + (C_GZ + 4 * fq) * 2) = w0;
    *(u32x2*)(Zp + (size_t)(wave * 32 + 16 + fr) * ZROWB + (C_GZ + 4 * fq) * 2) = w1;
}

template <int PASS>
__device__ __forceinline__ void lru_pass(CArgs& a, int l, int panel) {
    int tid_ = threadIdx.x; asm volatile("" : "+v"(tid_));
    const int lane = tid_ & 63, wave = tid_ >> 6;
    unsigned char* ws = a.ws;
    const int fr = lane & 15, fq = lane >> 4, h = wave, ch0 = h * 32 + 8 * fq;
    float cw[4][8], cb[8], br[8], bi[8], sp[8];
#pragma unroll
    for (int c = 0; c < 8; ++c) {
#pragma unroll
        for (int j = 0; j < 4; ++j) cw[j][c] = a.in[16][(size_t)(l * 4 + j) * 256 + ch0 + c];
        cb[c] = a.in[17][l * 256 + ch0 + c]; br[c] = a.in[19][l * 256 + ch0 + c]; bi[c] = a.in[21][l * 256 + ch0 + c];
        const float x = -a.in[22][l * 256 + ch0 + c];
        sp[c] = 8.f * (fmaxf(x, 0.f) + log1pf(expf(-fabsf(x))));
    }
    bf16x8 wrf[2], wif[2];
#pragma unroll
    for (int mt = 0; mt < 2; ++mt) { const int j = 8 * (fr >> 2) + 4 * mt + (fr & 3);
        wrf[mt] = *(const bf16x8*)((const bf16_t*)(ws + WS_LRUW) + (size_t)((l * 2 + 0) * 8 + h) * 1024 + j * 32 + 8 * fq);
        wif[mt] = *(const bf16x8*)((const bf16_t*)(ws + WS_LRUW) + (size_t)((l * 2 + 1) * 8 + h) * 1024 + j * 32 + 8 * fq); }
    const unsigned char* Zp = ws + WS_PANEL + (size_t)panel * PANEL_BYTES + P_Z;
    const unsigned char* Zprev = Zp - PANEL_BYTES;
    unsigned char* MIX = ws + WS_PANEL + (size_t)panel * PANEL_BYTES + P_MIX;
    const bool seq_start = (panel & 31) == 0;
    float hin[8], atot[8];
#pragma unroll
    for (int c = 0; c < 8; ++c) { hin[c] = (PASS == 2) ? ((const float*)(ws + WS_LRUB))[(size_t)panel * 256 + ch0 + c] : 0.f; atot[c] = 1.f; }
    u32x4 xn[4], gn = (u32x4){0u, 0u, 0u, 0u};
#define LRU_LOAD(tile_) do { const int t_ = (tile_) * 16 + fr; _Pragma("unroll") for (int j = 0; j < 4; ++j) { const int tt = t_ - 3 + j; xn[j] = (u32x4){0u, 0u, 0u, 0u}; \
            if (tt >= 0) xn[j] = *(const u32x4*)(Zp + (size_t)tt * ZROWB + (C_LX + ch0) * 2); \
            else if (!seq_start) xn[j] = *(const u32x4*)(Zprev + (size_t)(256 + tt) * ZROWB + (C_LX + ch0) * 2); } \
        if (PASS == 2) gn = *(const u32x4*)(Zp + (size_t)t_ * ZROWB + (C_LG + ch0) * 2); } while (0)
    LRU_LOAD(0);
    for (int tile = 0; tile < 16; ++tile) {
        const int t = tile * 16 + fr;
        float xc[8];
#pragma unroll
        for (int c = 0; c < 8; ++c) xc[c] = cb[c];
#pragma unroll
        for (int j = 0; j < 4; ++j) {
            const u32x4 xv = xn[j];
#pragma unroll
            for (int k = 0; k < 4; ++k) { xc[2 * k] += cw[j][2 * k] * bflo(xv[k]); xc[2 * k + 1] += cw[j][2 * k + 1] * bfhi(xv[k]); }
        }
        const u32x4 gv = gn;
        if (tile + 1 < 16) LRU_LOAD(tile + 1);
        u32x4 xp; xp.x = pk2(xc[0], xc[1]); xp.y = pk2(xc[2], xc[3]); xp.z = pk2(xc[4], xc[5]); xp.w = pk2(xc[6], xc[7]);
        const bf16x8 xcb = __builtin_bit_cast(bf16x8, xp);
        f32x4 ar[2], ai[2];
#pragma unroll
        for (int mt = 0; mt < 2; ++mt) { ar[mt] = mfma16(wrf[mt], xcb, (f32x4){0.f, 0.f, 0.f, 0.f}); ai[mt] = mfma16(wif[mt], xcb, (f32x4){0.f, 0.f, 0.f, 0.f}); }
        float A[8], B[8];
#pragma unroll
        for (int c = 0; c < 8; ++c) {
            const float gr = sigmoidf_(ar[c >> 2][c & 3] + br[c]), gi = sigmoidf_(ai[c >> 2][c & 3] + bi[c]);
            const float la = -gr * sp[c];
            const float x2 = 2.f * la;
            const float om = -x2 * (1.f + x2 * (0.5f + x2 * (0.16666667f + x2 * (0.041666668f + x2 * (0.0083333338f + x2 * 0.0013888889f)))));
            A[c] = __expf(la); B[c] = __builtin_amdgcn_sqrtf(fmaxf(om, 0.f)) * (gi * xc[c]);
        }
#pragma unroll
        for (int s = 1; s < 16; s <<= 1) {
#pragma unroll
            for (int c = 0; c < 8; ++c) { const float ap = __shfl_up(A[c], s, 16), bp = __shfl_up(B[c], s, 16);
                if (fr >= s) { B[c] = A[c] * bp + B[c]; A[c] = A[c] * ap; } }
        }
        if (PASS == 2) {
            float o[8];
#pragma unroll
            for (int k = 0; k < 4; ++k) { o[2 * k] = (A[2 * k] * hin[2 * k] + B[2 * k]) * gelu_tanh(bflo(gv[k])); o[2 * k + 1] = (A[2 * k + 1] * hin[2 * k + 1] + B[2 * k + 1]) * gelu_tanh(bfhi(gv[k])); }
            u32x4 w; w.x = pk2(o[0], o[1]); w.y = pk2(o[2], o[3]); w.z = pk2(o[4], o[5]); w.w = pk2(o[6], o[7]);
            *(u32x4*)(MIX + (size_t)t * 2048 + (768 + ch0) * 2) = w;
        }
        if (PASS == 1) {
            u32x4 w0, w1; w0.x = pk2(A[0], B[0]); w0.y = pk2(A[1], B[1]); w0.z = pk2(A[2], B[2]); w0.w = pk2(A[3], B[3]); w1.x = pk2(A[4], B[4]); w1.y = pk2(A[5], B[5]); w1.z = pk2(A[6], B[6]); w1.w = pk2(A[7], B[7]);
            u32x4* abp = (u32x4*)(ws + WS_LRUAB + (((size_t)panel * 256 + t) * 256 + ch0) * 4); abp[0] = w0; abp[1] = w1;
        }
        float a15[8], b15[8];
#pragma unroll
        for (int c = 0; c < 8; ++c) { a15[c] = __shfl(A[c], 15, 16); b15[c] = __shfl(B[c], 15, 16); hin[c] = a15[c] * hin[c] + b15[c]; atot[c] *= a15[c]; }
        if (PASS == 1 && fr == 0) {
            f32x4* cp = (f32x4*)(ws + WS_LRUC + (((size_t)panel * 16 + tile) * 256 + ch0) * 8);
            cp[0] = (f32x4){a15[0], b15[0], a15[1], b15[1]}; cp[1] = (f32x4){a15[2], b15[2], a15[3], b15[3]}; cp[2] = (f32x4){a15[4], b15[4], a15[5], b15[5]}; cp[3] = (f32x4){a15[6], b15[6], a15[7], b15[7]};
        }
    }
    if (PASS == 1 && fr == 0) {
#pragma unroll
        for (int c = 0; c < 8; ++c) { ((float*)(ws + WS_LRUA))[(size_t)panel * 256 + ch0 + c] = atot[c]; ((float*)(ws + WS_LRUB))[(size_t)panel * 256 + ch0 + c] = hin[c]; }
    }
}

__device__ __forceinline__ void lru_apply(CArgs& a, int l, int panel) {
    int tid_ = threadIdx.x; asm volatile("" : "+v"(tid_));
    const int lane = tid_ & 63, wave = tid_ >> 6;
    unsigned char* ws = a.ws;
    const int fr = lane & 15, fq = lane >> 4, ch0 = wave * 32 + 8 * fq;
    const unsigned char* Zp = ws + WS_PANEL + (size_t)panel * PANEL_BYTES + P_Z;
    unsigned char* MIX = ws + WS_PANEL + (size_t)panel * PANEL_BYTES + P_MIX;
    float hin[8];
#pragma unroll
    for (int c = 0; c < 8; ++c) hin[c] = ((const float*)(ws + WS_LRUB))[(size_t)panel * 256 + ch0 + c];
    u32x4 abn[2], gn; f32x4 cn[4];
#define LRU2_LOAD(tile_) do { const int t_ = (tile_) * 16 + fr; const u32x4* abp_ = (const u32x4*)(ws + WS_LRUAB + (((size_t)panel * 256 + t_) * 256 + ch0) * 4); abn[0] = abp_[0]; abn[1] = abp_[1]; \
        gn = *(const u32x4*)(Zp + (size_t)t_ * ZROWB + (C_LG + ch0) * 2); \
        const f32x4* cp_ = (const f32x4*)(ws + WS_LRUC + (((size_t)panel * 16 + (tile_)) * 256 + ch0) * 8); cn[0] = cp_[0]; cn[1] = cp_[1]; cn[2] = cp_[2]; cn[3] = cp_[3]; } while (0)
    LRU2_LOAD(0);
    for (int tile = 0; tile < 16; ++tile) {
        const int t = tile * 16 + fr;
        const u32x4 ab0 = abn[0], ab1 = abn[1], gv = gn; const f32x4 c0 = cn[0], c1 = cn[1], c2 = cn[2], c3 = cn[3];
        if (tile + 1 < 16) LRU2_LOAD(tile + 1);
        float o[8];
#pragma unroll
        for (int k = 0; k < 4; ++k) {
            o[k] = bflo(ab0[k]) * hin[k] + bfhi(ab0[k]); o[4 + k] = bflo(ab1[k]) * hin[4 + k] + bfhi(ab1[k]);
        }
#pragma unroll
        for (int k = 0; k < 4; ++k) { o[2 * k] *= gelu_tanh(bflo(gv[k])); o[2 * k + 1] *= gelu_tanh(bfhi(gv[k])); }
        u32x4 w; w.x = pk2(o[0], o[1]); w.y = pk2(o[2], o[3]); w.z = pk2(o[4], o[5]); w.w = pk2(o[6], o[7]);
        *(u32x4*)(MIX + (size_t)t * 2048 + (768 + ch0) * 2) = w;
        hin[0] = c0[0] * hin[0] + c0[1]; hin[1] = c0[2] * hin[1] + c0[3]; hin[2] = c1[0] * hin[2] + c1[1]; hin[3] = c1[2] * hin[3] + c1[3];
        hin[4] = c2[0] * hin[4] + c2[1]; hin[5] = c2[2] * hin[5] + c2[3]; hin[6] = c3[0] * hin[6] + c3[1]; hin[7] = c3[2] * hin[7] + c3[3];
    }
#undef LRU2_LOAD
}

template <int PASS>
__device__ __forceinline__ void s5_pass(CArgs& a, LAS unsigned char* lds, int l, int panel) {
    int tid_ = threadIdx.x; asm volatile("" : "+v"(tid_));
    const int lane = tid_ & 63, wave = __builtin_amdgcn_readfirstlane(tid_ >> 6);
    unsigned char* ws = a.ws;
    const int fr = lane & 15, fq = lane >> 4;
    LAS float* hl = (LAS float*)(lds + wave * 12288);
    LAS bf16_t* xh = (LAS bf16_t*)(lds + wave * 12288 + 8192);
    const unsigned char* Zp = ws + WS_PANEL + (size_t)panel * PANEL_BYTES + P_Z;
    unsigned char* YS5 = ws + WS_PANEL + (size_t)panel * PANEL_BYTES + P_YS5;
    for (int gi = 0; gi < 2; ++gi) {
        const int g = 2 * wave + gi;
        const bf16_t* Wg = (const bf16_t*)(ws + WS_S5W) + (size_t)(l * 16 + g) * 128 * 64;
        const bf16_t* Mg = (const bf16_t*)(ws + WS_S5M) + (size_t)(l * 16 + g) * 64 * 192;
        bf16x8 wf[8][2];
#pragma unroll
        for (int mt = 0; mt < 8; ++mt)
#pragma unroll
            for (int ks = 0; ks < 2; ++ks) wf[mt][ks] = *(const bf16x8*)(Wg + (size_t)(16 * mt + fr) * 64 + 32 * ks + 8 * fq);
        bf16x8 mf[4][4];
        f32x4 dsk = (f32x4){0.f, 0.f, 0.f, 0.f};
        if (PASS == 2) {
#pragma unroll
            for (int mt = 0; mt < 4; ++mt)
#pragma unroll
                for (int ks = 0; ks < 4; ++ks) mf[mt][ks] = *(const bf16x8*)(Mg + (size_t)(16 * mt + fr) * 192 + 64 + 32 * ks + 8 * fq);
            dsk = *(const f32x4*)(a.in[11] + l * 256 + g * 16 + 4 * fq);
        }
        const float* Ap = (const float*)(ws + WS_S5A) + ((size_t)(l * 16 + g) * 64 + lane) * 4;
        const float a4r = Ap[0], a4i = Ap[1];
        float* Hg = (float*)(ws + WS_S5H) + ((size_t)panel * 16 + g) * 128 + 2 * lane;
        float Hr = 0.f, Hi = 0.f;
        if (PASS == 2) { Hr = Hg[0]; Hi = Hg[1]; }
#pragma unroll 1
        for (int nt = 0; nt < 4; ++nt) {
            bf16x8 xf[2];
#pragma unroll
            for (int ks = 0; ks < 2; ++ks) xf[ks] = *(const bf16x8*)(Zp + (size_t)(64 * nt + 4 * fr + 2 * ks + (fq >> 1)) * ZROWB + (C_S5U + g * 16 + (fq & 1) * 8) * 2);
#pragma unroll
            for (int mt = 0; mt < 8; ++mt) {
                f32x4 acc = mfma16(wf[mt][0], xf[0], (f32x4){0.f, 0.f, 0.f, 0.f});
                acc = mfma16(wf[mt][1], xf[1], acc);
                *(LAS f32x4*)(hl + fr * 128 + 16 * mt + 4 * fq) = acc;
            }
            lds_fence();
            for (int j = 0; j < 16; ++j) {
                if (PASS == 2) *(LAS unsigned*)(xh + j * 128 + 2 * lane) = pk2(Hr, Hi);
                const f32x2 lc = *(LAS f32x2*)(hl + j * 128 + 2 * lane);
                const float nr = a4r * Hr - a4i * Hi + lc.x, ni = a4r * Hi + a4i * Hr + lc.y;
                Hr = nr; Hi = ni;
            }
            lds_fence();
            if (PASS == 2) {
                bf16x8 xhf[4];
#pragma unroll
                for (int k4 = 0; k4 < 4; ++k4) xhf[k4] = *(const LAS bf16x8*)(xh + fr * 128 + 32 * k4 + 8 * fq);
#pragma unroll
                for (int mt = 0; mt < 4; ++mt) {
                    f32x4 acc = (f32x4){0.f, 0.f, 0.f, 0.f};
#pragma unroll
                    for (int ks = 0; ks < 2; ++ks) if (2 * ks <= mt) acc = mfma16(*(const bf16x8*)(Mg + (size_t)(16 * mt + fr) * 192 + 32 * ks + 8 * fq), xf[ks], acc);
#pragma unroll
                    for (int k4 = 0; k4 < 4; ++k4) acc = mfma16(mf[mt][k4], xhf[k4], acc);
                    const int tok = (16 * nt + fr) * 4 + mt, ch = g * 16 + 4 * fq;
                    const u32x2 uv = *(const u32x2*)(Zp + (size_t)tok * ZROWB + (C_S5U + ch) * 2);
                    const float y0 = gelu_tanh(acc[0] + dsk[0] * bflo(uv.x)), y1 = gelu_tanh(acc[1] + dsk[1] * bfhi(uv.x));
                    const float y2 = gelu_tanh(acc[2] + dsk[2] * bflo(uv.y)), y3 = gelu_tanh(acc[3] + dsk[3] * bfhi(uv.y));
                    u32x2 w; w.x = pk2(y0, y1); w.y = pk2(y2, y3);
                    *(u32x2*)(YS5 + (size_t)tok * 512 + ch * 2) = w;
                }
            }
            lds_fence();
        }
        if (PASS == 1) { Hg[0] = Hr; Hg[1] = Hi; }
    }
}

constexpr int GL_QE = 0, GL_KE = 9216, GL_KDT = 18432, GL_VT = 27648, GL_SC = 46080, GL_ST = 55296, GL_GP = 73728, GL_SS = 75776, GL_DK = 76288, GL_X = 77824;
constexpr int GXS = 68;
constexpr int GRS = 144;
template <int PASS>
__device__ __forceinline__ void gla_pass(CArgs& a, LAS unsigned char* lds, int l, int panel) {
    int tid = threadIdx.x; asm volatile("" : "+v"(tid));
    const int lane = tid & 63, wave = tid >> 6;
    unsigned char* ws = a.ws;
    const int fr = lane & 15, fq = lane >> 4;
    const int d_ = lane, tq = wave;
    const int e_ = tid & 127, tq4 = tid >> 7;
    const int wq = wave & 3, wh = wave >> 2;
    const unsigned char* Zp = ws + WS_PANEL + (size_t)panel * PANEL_BYTES + P_Z;
    unsigned char* MIX = ws + WS_PANEL + (size_t)panel * PANEL_BYTES + P_MIX;
    LAS float* GP = (LAS float*)(lds + GL_GP); LAS float* SS = (LAS float*)(lds + GL_SS); LAS float* DK = (LAS float*)(lds + GL_DK);
    u32x4 pgz[2]; bf16_t pq[8], pk[8]; unsigned pv[8]; u32x2 pr[4];
#define GLA_LOAD(it_) do { const int h_ = (it_) >> 2, row0_ = ((it_) & 3) * 64; \
        _Pragma("unroll") for (int i = 0; i < 2; ++i) { pgz[i] = (u32x4){0u, 0u, 0u, 0u}; if (fq < 2) pgz[i] = *(const u32x4*)(Zp + (size_t)(row0_ + 16 * (2 * wh + i) + fr) * ZROWB + (C_GZ + 8 * fq) * 2); } \
        _Pragma("unroll") for (int i = 0; i < 8; ++i) { const unsigned char* zr = Zp + (size_t)(row0_ + tq * 8 + i) * ZROWB; \
            if (PASS == 2) pq[i] = *(const bf16_t*)(zr + (C_Q + h_ * 64 + d_) * 2); pk[i] = *(const bf16_t*)(zr + (C_K + h_ * 64 + d_) * 2); } \
        _Pragma("unroll") for (int i = 0; i < 8; ++i) pv[i] = *(const unsigned*)(Zp + (size_t)(row0_ + tq * 8 + i) * ZROWB + (C_V + h_ * 128 + 2 * d_) * 2); \
        if (PASS == 2) { _Pragma("unroll") for (int k = 0; k < 4; ++k) pr[k] = *(const u32x2*)(Zp + (size_t)(row0_ + 16 * wq + fr) * ZROWB + (C_R + h_ * 128 + 16 * (wh * 4 + k) + 4 * fq) * 2); } } while (0)
    GLA_LOAD(0);
    float bg = 0.f; f32x4 st[4]; float dprod = 1.f;
#pragma unroll
    for (int k = 0; k < 4; ++k) st[k] = (f32x4){0.f, 0.f, 0.f, 0.f};
    float* Sg = (float*)(ws + WS_GLAS) + ((size_t)panel * 4) * 8192;
    bf16x8 wfr = (bf16x8){0, 0, 0, 0, 0, 0, 0, 0};
#define GLA_WFRAG(h_) do { u32x4 w_ = (u32x4){0u, 0u, 0u, 0u}; if (fq < 2) { const float* wp_ = a.in[13] + (size_t)(l * 16 + 8 * fq) * 256 + (h_) * 64 + 16 * wq + fr; \
        w_.x = pk2(wp_[0], wp_[256]); w_.y = pk2(wp_[512], wp_[768]); w_.z = pk2(wp_[1024], wp_[1280]); w_.w = pk2(wp_[1536], wp_[1792]); } wfr = __builtin_bit_cast(bf16x8, w_); } while (0)
#define GLA_XTILE(g0_, g1_) do { const f32x4 x0_ = mfma16(wfr, __builtin_bit_cast(bf16x8, g0_), (f32x4){0.f, 0.f, 0.f, 0.f}), x1_ = mfma16(wfr, __builtin_bit_cast(bf16x8, g1_), (f32x4){0.f, 0.f, 0.f, 0.f}); \
        *(LAS f32x4*)(lds + GL_X + ((16 * (2 * wh) + fr) * GXS + 16 * wq + 4 * fq) * 4) = x0_; *(LAS f32x4*)(lds + GL_X + ((16 * (2 * wh + 1) + fr) * GXS + 16 * wq + 4 * fq) * 4) = x1_; } while (0)
    GLA_WFRAG(0);
    GLA_XTILE(pgz[0], pgz[1]);
    __syncthreads();
#pragma unroll 1
    for (int it = 0; it < 16; ++it) {
        const int h = it >> 2, c = it & 3, row0 = c * 64;
        if (c == 0) {
            bg = a.in[14][l * 256 + h * 64 + d_];
            Sg = (float*)(ws + WS_GLAS) + ((size_t)panel * 4 + h) * 8192;
#pragma unroll
            for (int k = 0; k < 4; ++k) {
                const int et = wh * 4 + k;
#pragma unroll
                for (int r = 0; r < 4; ++r) {
                    const int e = 16 * et + 4 * fq + r, d = 16 * wq + fr;
                    if (PASS == 2) { const float v = Sg[e * 64 + d]; st[k][r] = v; *(LAS bf16_t*)(lds + GL_ST + e * GRS + d * 2) = (bf16_t)f2bf(v); }
                    else st[k][r] = 0.f;
                }
            }
            dprod = 1.f;
        }
        float qv[8], kv[8]; unsigned vpk[8]; u32x2 rvv[4];
#pragma unroll
        for (int i = 0; i < 8; ++i) { qv[i] = (PASS == 2) ? bf1(pq[i]) : 0.f; kv[i] = bf1(pk[i]); vpk[i] = pv[i]; }
#pragma unroll
        for (int k = 0; k < 4; ++k) rvv[k] = pr[k];
        if (it + 1 < 16) GLA_LOAD(it + 1);
        float gl[8];
#pragma unroll
        for (int i = 0; i < 8; ++i) {
            const float x = bg + *(const LAS float*)(lds + GL_X + ((tq * 8 + i) * GXS + d_) * 4);
            const float ls = fminf(x, 0.f) - __logf(1.f + __expf(-fabsf(x)));
            gl[i] = ls * 0.0625f + (i ? gl[i - 1] : 0.f);
        }
        GP[tq * 64 + d_] = gl[7];
        __syncthreads();
        float off = 0.f, tot = 0.f;
#pragma unroll
        for (int k = 0; k < 8; ++k) { const float v = GP[k * 64 + d_]; tot += v; if (k < tq) off += v; }
        float kd[8];
#pragma unroll
        for (int i = 0; i < 8; ++i) {
            const float bc = off + gl[i];
            if (PASS == 2) {
                const float eb = __expf(bc);
                const unsigned qk = pk2(qv[i] * 0.125f * eb, kv[i] * __builtin_amdgcn_rcpf(eb));
                *(LAS bf16_t*)(lds + GL_QE + (tq * 8 + i) * GRS + d_ * 2) = (bf16_t)(qk & 0xffffu);
                *(LAS bf16_t*)(lds + GL_KE + (tq * 8 + i) * GRS + d_ * 2) = (bf16_t)(qk >> 16);
            }
            kd[i] = kv[i] * __expf(tot - bc);
        }
        { u32x4 w; w.x = pk2(kd[0], kd[1]); w.y = pk2(kd[2], kd[3]); w.z = pk2(kd[4], kd[5]); w.w = pk2(kd[6], kd[7]);
          *(LAS u32x4*)(lds + GL_KDT + d_ * GRS + tq * 16) = w; }
        if (tq == 0) DK[d_] = __expf(tot);
        {
            u32x4 w0, w1;
            w0.x = __builtin_amdgcn_perm(vpk[1], vpk[0], 0x05040100u); w0.y = __builtin_amdgcn_perm(vpk[3], vpk[2], 0x05040100u); w0.z = __builtin_amdgcn_perm(vpk[5], vpk[4], 0x05040100u); w0.w = __builtin_amdgcn_perm(vpk[7], vpk[6], 0x05040100u);
            w1.x = __builtin_amdgcn_perm(vpk[1], vpk[0], 0x07060302u); w1.y = __builtin_amdgcn_perm(vpk[3], vpk[2], 0x07060302u); w1.z = __builtin_amdgcn_perm(vpk[5], vpk[4], 0x07060302u); w1.w = __builtin_amdgcn_perm(vpk[7], vpk[6], 0x07060302u);
            *(LAS u32x4*)(lds + GL_VT + (2 * d_) * GRS + tq * 16) = w0; *(LAS u32x4*)(lds + GL_VT + (2 * d_ + 1) * GRS + tq * 16) = w1; }
        __syncthreads();
        f32x4 o[4];
        if (PASS == 2) {
#pragma unroll
            for (int jj = 0; jj < 2; ++jj) {
                const int jt = 2 * wh + jj;
                f32x4 acc = (f32x4){0.f, 0.f, 0.f, 0.f};
#pragma unroll
                for (int ks = 0; ks < 2; ++ks) acc = mfma16(*(const LAS bf16x8*)(lds + GL_KE + (16 * jt + fr) * GRS + (32 * ks + 8 * fq) * 2),
                                                            *(const LAS bf16x8*)(lds + GL_QE + (16 * wq + fr) * GRS + (32 * ks + 8 * fq) * 2), acc);
                const int i = 16 * wq + fr, j0 = 16 * jt + 4 * fq;
                u32x2 w; w.x = pk2(j0 <= i ? acc[0] : 0.f, j0 + 1 <= i ? acc[1] : 0.f); w.y = pk2(j0 + 2 <= i ? acc[2] : 0.f, j0 + 3 <= i ? acc[3] : 0.f);
                *(LAS u32x2*)(lds + GL_SC + i * GRS + j0 * 2) = w;
            }
            __syncthreads();
            float ss = 0.f;
#pragma unroll
            for (int k = 0; k < 4; ++k) {
                const int et = wh * 4 + k;
                f32x4 acc = (f32x4){0.f, 0.f, 0.f, 0.f};
#pragma unroll
                for (int ks = 0; ks < 2; ++ks) {
                    if (ks == 0 || wq >= 2) acc = mfma16(*(const LAS bf16x8*)(lds + GL_VT + (16 * et + fr) * GRS + (32 * ks + 8 * fq) * 2),
                                                         *(const LAS bf16x8*)(lds + GL_SC + (16 * wq + fr) * GRS + (32 * ks + 8 * fq) * 2), acc);
                }
#pragma unroll
                for (int ks = 0; ks < 2; ++ks) acc = mfma16(*(const LAS bf16x8*)(lds + GL_ST + (16 * et + fr) * GRS + (32 * ks + 8 * fq) * 2),
                                                            *(const LAS bf16x8*)(lds + GL_QE + (16 * wq + fr) * GRS + (32 * ks + 8 * fq) * 2), acc);
                o[k] = acc; ss += (acc[0] * acc[0] + acc[1] * acc[1]) + (acc[2] * acc[2] + acc[3] * acc[3]);
            }
            ss += __shfl_xor(ss, 16); ss += __shfl_xor(ss, 32);
            if (fq == 0) SS[(16 * wq + fr) * 2 + wh] = ss;
        }
        {
            const float dk = DK[16 * wq + fr];
            dprod *= dk;
#pragma unroll
            for (int k = 0; k < 4; ++k) {
                const int et = wh * 4 + k;
                f32x4 acc = st[k] * dk;
#pragma unroll
                for (int ks = 0; ks < 2; ++ks) acc = mfma16(*(const LAS bf16x8*)(lds + GL_VT + (16 * et + fr) * GRS + (32 * ks + 8 * fq) * 2),
                                                            *(const LAS bf16x8*)(lds + GL_KDT + (16 * wq + fr) * GRS + (32 * ks + 8 * fq) * 2), acc);
                st[k] = acc;
            }
        }
        if (it + 1 < 16) {
            if (c == 3) GLA_WFRAG(h + 1);
            GLA_XTILE(pgz[0], pgz[1]);
        }
        __syncthreads();
        if (PASS == 2) {
            const int i = 16 * wq + fr;
            const float rs = rsqrtf((SS[i * 2] + SS[i * 2 + 1]) * (1.f / 128.f) + 1e-6f);
#pragma unroll
            for (int k = 0; k < 4; ++k) {
                const int e0 = 16 * (wh * 4 + k) + 4 * fq;
                const f32x4 ng = *(const f32x4*)(a.in[15] + l * 128 + e0);
                const u32x2 rv = rvv[k];
                const float r0 = bflo(rv.x), r1 = bfhi(rv.x), r2 = bflo(rv.y), r3 = bfhi(rv.y);
                u32x2 w; w.x = pk2(o[k][0] * rs * ng[0] * r0 * sigmoidf_(r0), o[k][1] * rs * ng[1] * r1 * sigmoidf_(r1));
                w.y = pk2(o[k][2] * rs * ng[2] * r2 * sigmoidf_(r2), o[k][3] * rs * ng[3] * r3 * sigmoidf_(r3));
                *(u32x2*)(MIX + (size_t)(row0 + i) * 2048 + (256 + h * 128 + e0) * 2) = w;
                { const unsigned s01 = pk2(st[k][0], st[k][1]), s23 = pk2(st[k][2], st[k][3]);
                  *(LAS bf16_t*)(lds + GL_ST + (e0 + 0) * GRS + (16 * wq + fr) * 2) = (bf16_t)(s01 & 0xffffu); *(LAS bf16_t*)(lds + GL_ST + (e0 + 1) * GRS + (16 * wq + fr) * 2) = (bf16_t)(s01 >> 16);
                  *(LAS bf16_t*)(lds + GL_ST + (e0 + 2) * GRS + (16 * wq + fr) * 2) = (bf16_t)(s23 & 0xffffu); *(LAS bf16_t*)(lds + GL_ST + (e0 + 3) * GRS + (16 * wq + fr) * 2) = (bf16_t)(s23 >> 16); }
            }
        }
        if (c == 3) {
            if (PASS == 1) {
#pragma unroll
                for (int k = 0; k < 4; ++k)
#pragma unroll
                    for (int r = 0; r < 4; ++r) Sg[(16 * (wh * 4 + k) + 4 * fq + r) * 64 + 16 * wq + fr] = st[k][r];
                if (wh == 0 && fq == 0) ((float*)(ws + WS_GLAD))[((size_t)panel * 4 + h) * 64 + 16 * wq + fr] = dprod;
            }
            __syncthreads();
        }
    }
#undef GLA_LOAD
#undef GLA_WFRAG
#undef GLA_XTILE
}

__device__ __forceinline__ void scan_phase(CArgs& a, int l) {
    int tid = threadIdx.x; asm volatile("" : "+v"(tid));
    unsigned char* ws = a.ws;
    const int gt = blockIdx.x * 512 + tid;
    for (int idx = gt; idx < 8 * 32768; idx += 131072) {
        const int b = idx >> 15, r = idx & 32767, hh = r >> 13, d = r & 63;
        float* S = (float*)(ws + WS_GLAS) + (size_t)(b * 32) * 32768 + r;
        const float* D = (const float*)(ws + WS_GLAD) + (size_t)(b * 32) * 256 + hh * 64 + d;
        float loc[32], dec[32];
#pragma unroll
        for (int s = 0; s < 32; ++s) { loc[s] = S[(size_t)s * 32768]; dec[s] = D[(size_t)s * 256]; }
        float run = 0.f;
#pragma unroll
        for (int s = 0; s < 32; ++s) { S[(size_t)s * 32768] = run; run = dec[s] * run + loc[s]; }
    }
    if (gt < 2048) {
        const int b = gt >> 8, ch = gt & 255;
        float* B = (float*)(ws + WS_LRUB) + (size_t)(b * 32) * 256 + ch; const float* A = (const float*)(ws + WS_LRUA) + (size_t)(b * 32) * 256 + ch;
        float run = 0.f;
        for (int s = 0; s < 32; ++s) { const float loc = B[s * 256], dec = A[s * 256]; B[s * 256] = run; run = dec * run + loc; }
    } else if (gt >= 4096 && gt < 4096 + 8192) {
        const int q = gt - 4096, b = q >> 10, g = (q >> 6) & 15, p = q & 63;
        const float* Ap = (const float*)(ws + WS_S5A) + ((size_t)(l * 16 + g) * 64 + p) * 4;
        const float ar = Ap[2], ai = Ap[3];
        float* H = (float*)(ws + WS_S5H) + ((size_t)(b * 32) * 16 + g) * 128 + 2 * p;
        float rr = 0.f, ri = 0.f;
        for (int s = 0; s < 32; ++s) { const float lr = H[(size_t)s * 2048], li = H[(size_t)s * 2048 + 1]; H[(size_t)s * 2048] = rr; H[(size_t)s * 2048 + 1] = ri;
            const float nr = ar * rr - ai * ri + lr, ni = ar * ri + ai * rr + li; rr = nr; ri = ni; }
    }
}

#define XB_TMO      128
#define XB_XCNT(j)  (256  + 64 * (j))
#define XB_XSUB(j)  (1280 + 64 * (j))
#define XB_XGEN(j)  (2304 + 64 * (j))
#define XB_TOP      3328
#define XB_TOPGEN   3392
#define XCD_BAR_WORDS 3456
#define XB_SPIN_CAP (1u << 18)

__device__ __forceinline__ unsigned xb_ld(unsigned* p)              { return __hip_atomic_load(p, __ATOMIC_RELAXED, __HIP_MEMORY_SCOPE_AGENT); }
__device__ __forceinline__ unsigned xb_add(unsigned* p, unsigned v) { return __hip_atomic_fetch_add(p, v, __ATOMIC_RELAXED, __HIP_MEMORY_SCOPE_AGENT); }
__device__ __forceinline__ unsigned xb_xcc_id() { return (unsigned)__builtin_amdgcn_s_getreg((3 << 11) | 20) & 0xFu; }
#define XB_SPIN(cond, bar) do { unsigned _sp = 0; while (cond) { __builtin_amdgcn_s_sleep(1); \
    if ((++_sp & 255u) == 0u) { if (xb_ld(&(bar)[XB_TMO])) break; if (_sp > XB_SPIN_CAP) { atomicAdd(&(bar)[XB_TMO], 1u); break; } } } } while (0)

struct XcdBarrier {
    unsigned* bar; unsigned x;
    volatile LAS unsigned* st;
};

__device__ __forceinline__ XcdBarrier xcd_barrier_post(unsigned* bar, volatile LAS unsigned* st) {
    XcdBarrier b; b.bar = bar; b.x = xb_xcc_id(); b.st = st;
    if (threadIdx.x == 0) (void)xb_add(&bar[XB_XCNT(b.x)], 1u);
    return b;
}
__device__ __forceinline__ void xcd_barrier_complete(unsigned* bar, unsigned x, unsigned& nloc, unsigned& nx) {
    const unsigned G = gridDim.x * gridDim.y * gridDim.z;
    unsigned sum, cnt, mine, sp = 0u;
    for (;;) {
        sum = 0u; cnt = 0u; mine = 0u;
#pragma unroll
        for (unsigned j = 0; j < 16; ++j) { const unsigned c = xb_ld(&bar[XB_XCNT(j)]); sum += c; cnt += (c > 0u) ? 1u : 0u; mine = (j == x) ? c : mine; }
        if (sum == G) break;
        __builtin_amdgcn_s_sleep(1);
        if ((++sp & 255u) == 0u) { if (xb_ld(&bar[XB_TMO])) break; if (sp > XB_SPIN_CAP) { atomicAdd(&bar[XB_TMO], 1u); break; } }
    }
    nloc = mine > 0u ? mine : 1u; nx = cnt > 0u ? cnt : 1u;
}

__device__ __forceinline__ void xcd_barrier(const XcdBarrier& b) {
    asm volatile("s_waitcnt vmcnt(0)" ::: "memory");
    __syncthreads();
    if (threadIdx.x == 0) {
        unsigned* bar = b.bar;
        __builtin_amdgcn_s_waitcnt(0);
        unsigned nloc = b.st[0], nx = b.st[1];
        if (nloc == 0u) { xcd_barrier_complete(bar, b.x, nloc, nx); b.st[0] = nloc; b.st[1] = nx; }
        const unsigned old = xb_add(&bar[XB_XSUB(b.x)], 1u);
        const unsigned gen = old / nloc;
        if (old + 1u == (gen + 1u) * nloc) {
            __builtin_amdgcn_fence(__ATOMIC_RELEASE, "agent");
            asm volatile("s_waitcnt vmcnt(0)" ::: "memory");
            const unsigned og = xb_add(&bar[XB_TOP], 1u);
            const unsigned tg = og / nx;
            if (og + 1u == (tg + 1u) * nx) xb_add(&bar[XB_TOPGEN], 1u);
            else XB_SPIN(xb_ld(&bar[XB_TOPGEN]) == tg, bar);
            __builtin_amdgcn_fence(__ATOMIC_ACQUIRE, "agent");
            xb_add(&bar[XB_XGEN(b.x)], 1u);
            asm volatile("s_waitcnt vmcnt(0)" ::: "memory");
        } else {
            XB_SPIN(xb_ld(&bar[XB_XGEN(b.x)]) == gen, bar);
            __builtin_amdgcn_fence(__ATOMIC_ACQUIRE, "agent");
            asm volatile("s_waitcnt vmcnt(0)" ::: "memory");
        }
    }
    __syncthreads();
}


__global__ void __launch_bounds__(512, 2) fwd_megakernel(Args a) {
    extern __shared__ __attribute__((aligned(16))) unsigned char lds_raw[];
    LAS unsigned char* lds = (LAS unsigned char*)lds_raw;
    cg::grid_group grid = cg::this_grid();
    const int panel = blockIdx.x;
    if (threadIdx.x < 2) ((LAS unsigned*)(lds + LDS_XB))[threadIdx.x] = 0u;
    __syncthreads();
    const XcdBarrier xbar = xcd_barrier_post((unsigned*)kargs()->ws, (volatile LAS unsigned*)(lds + LDS_XB));
#define PHASE_PTRS() CArgs* ka = kargs(); unsigned char* ws = ka->ws; unsigned char* PB = ws + WS_PANEL + (size_t)panel * PANEL_BYTES; \
        bf16_t* HBp = (bf16_t*)(ws + WS_HB) + (size_t)panel * 256 * DM; float* Hp = ka->out + (size_t)panel * 256 * DM; (void)PB; (void)HBp; (void)Hp

#ifndef NO_PRO
    prologue(*kargs(), lds, panel, (int)gridDim.x);
#endif
    grid.sync();

#ifdef ONE_LAYER
    for (int l = 0; l < 1; ++l) {
#else
    for (int l = 0; l < NLAYER; ++l) {
#endif
        gz_phase(*kargs(), l, panel);
        {
            PHASE_PTRS();
            pg8::Gemm g{HBp, (const bf16_t*)(ws + WS_WIN) + (size_t)l * DINP * DM, DM}; pg8::PanelOrder S{NZ_MAIN / 256};
            pg8::EpiBf16<0> E{(bf16_t*)(PB + P_Z), DINP};
#ifndef NO_G1
            pg8::gemm_phase(lds, g, S, E);
#if REP_GEMM
            block_fence(); pg8::gemm_phase(lds, g, S, E);
#endif
#endif
        }
        xcd_barrier(xbar);
#ifndef NO_LRU
        lru_pass<1>(*kargs(), l, panel);
#endif
#ifndef NO_S5
        s5_pass<1>(*kargs(), lds, l, panel);
#endif
        __syncthreads();
#ifndef NO_GLA
        gla_pass<1>(*kargs(), lds, l, panel);
#endif
#if REP_MIX
        __syncthreads(); lru_pass<1>(*kargs(), l, panel); s5_pass<1>(*kargs(), lds, l, panel); __syncthreads(); gla_pass<1>(*kargs(), lds, l, panel);
#endif
#if REP_GLA
        __syncthreads(); gla_pass<1>(*kargs(), lds, l, panel);
#endif
#if REP_S5
        __syncthreads(); s5_pass<1>(*kargs(), lds, l, panel); __syncthreads();
#endif
        xcd_barrier(xbar);
#ifndef NO_SCAN
        scan_phase(*kargs(), l);
#endif
        xcd_barrier(xbar);
#ifndef NO_LRU
        lru_apply(*kargs(), l, panel);
#endif
#ifndef NO_S5
        s5_pass<2>(*kargs(), lds, l, panel);
#endif
        __syncthreads();
#ifndef NO_GLA
        gla_pass<2>(*kargs(), lds, l, panel);
#endif
#if REP_MIX
        __syncthreads(); lru_apply(*kargs(), l, panel); s5_pass<2>(*kargs(), lds, l, panel); __syncthreads(); gla_pass<2>(*kargs(), lds, l, panel);
#endif
#if REP_GLA
        __syncthreads(); gla_pass<2>(*kargs(), lds, l, panel);
#endif
#if REP_S5
        __syncthreads(); s5_pass<2>(*kargs(), lds, l, panel); __syncthreads();
#endif
        block_fence();
        {
            PHASE_PTRS();
            pg8::Gemm g{(const bf16_t*)(PB + P_YS5), (const bf16_t*)(ws + WS_WGLU) + (size_t)l * 256 * 256, 256}; pg8::PanelOrder S{1};
            pg8::EpiGlu E{(const bf16_t*)(PB + P_YS5), 256, (bf16_t*)(PB + P_MIX), DM};
#ifndef NO_G2
            pg8::gemm_phase(lds, g, S, E);
#endif
        }
        block_fence();
        {
            PHASE_PTRS();
            pg8::Gemm g{(const bf16_t*)(PB + P_MIX), (const bf16_t*)(ws + WS_WOUT) + (size_t)l * DM * DM, DM}; pg8::PanelOrder S{DM / 256};
            pg8::EpiRes E{HBp, DM, ALPHA};
#ifndef NO_G3
            pg8::gemm_phase(lds, g, S, E);
#endif
        }
        block_fence();
        { PHASE_PTRS(); ln_panel_b(HBp, nullptr, ka->in[24] + l * DM, ka->in[25] + l * DM); }
        block_fence();
        {
            PHASE_PTRS();
            pg8::Gemm g{HBp, (const bf16_t*)(ws + WS_W1) + (size_t)l * DFF * DM, DM}; pg8::PanelOrder S{DFF / 256};
            pg8::EpiBf16<1> E{(bf16_t*)(PB + P_HID), DFF};
#ifndef NO_G4
            pg8::gemm_phase(lds, g, S, E);
#if REP_GEMM
            block_fence(); pg8::gemm_phase(lds, g, S, E);
#endif
#endif
        }
        block_fence();
        {
            PHASE_PTRS();
            pg8::Gemm g{(const bf16_t*)(PB + P_HID), (const bf16_t*)(ws + WS_W2) + (size_t)l * DM * DFF, DFF}; pg8::PanelOrder S{DM / 256};
            pg8::EpiRes E{HBp, DM, ALPHA};
#ifndef NO_G5
            pg8::gemm_phase(lds, g, S, E);
#endif
        }
        block_fence();
        { PHASE_PTRS(); ln_panel_b(HBp, (l + 1 == NLAYER) ? Hp : nullptr, ka->in[28] + l * DM, ka->in[29] + l * DM); }
        block_fence();
    }
}

extern "C" void kernel_launch(void* const* d_in, const int* in_sizes, int n_in, void* d_out, int out_size, void* d_ws, size_t ws_size, hipStream_t stream) {
    static int ready = 0;
    if (ready == 0) {
        if (n_in != 30 || in_sizes[0] != M_TOK * DM || out_size != M_TOK * DM || ws_size < WS_END) {
            fprintf(stderr, "kernel_launch: unexpected shapes (n_in %d, in0 %d, out %d, ws %zu)\n", n_in, n_in > 0 ? in_sizes[0] : -1, out_size, ws_size); ready = -1; return; }
        if (hipFuncSetAttribute((const void*)fwd_megakernel, hipFuncAttributeMaxDynamicSharedMemorySize, LDS_BYTES) != hipSuccess) { fprintf(stderr, "kernel_launch: hipFuncSetAttribute failed\n"); ready = -1; return; }
        int dev = 0, cus = 0, per_cu = 0;
        hipGetDevice(&dev); hipDeviceGetAttribute(&cus, hipDeviceAttributeMultiprocessorCount, dev);
        hipOccupancyMaxActiveBlocksPerMultiprocessor(&per_cu, (const void*)fwd_megakernel, 512, LDS_BYTES);
        if (cus * per_cu < NPANEL) fprintf(stderr, "kernel_launch: note: %d CUs x %d blocks/CU < %d workgroups\n", cus, per_cu, NPANEL);
        (void)hipGetLastError();
        ready = 1;
    }
    if (ready < 0) return;
    if (hipMemsetAsync(d_ws, 0, 16384, stream) != hipSuccess) { fprintf(stderr, "kernel_launch: hipMemsetAsync failed\n"); return; }
    Args a{};
    for (int i = 0; i < 30; ++i) a.in[i] = (const float*)d_in[i];
    a.out = (float*)d_out; a.ws = (unsigned char*)d_ws;
    void* args[] = {&a};
    hipError_t e = hipLaunchCooperativeKernel((const void*)fwd_megakernel, dim3(NPANEL), dim3(512), args, LDS_BYTES, stream);
    if (e != hipSuccess) fprintf(stderr, "kernel_launch: cooperative launch failed: %s\n", hipGetErrorString(e));
}
```

```cpp
#include <hip/hip_runtime.h>
#include <hip/hip_cooperative_groups.h>
#include <cstdio>
#include <cstdint>
namespace cg = cooperative_groups;
#ifndef REP_GEMM
#define REP_GEMM 0
#endif
#ifndef REP_GLA
#define REP_GLA 0
#endif
#ifndef REP_S5
#define REP_S5 0
#endif
#ifndef REP_MIX
#define REP_MIX 0
#endif

#define LAS __attribute__((address_space(3)))
typedef unsigned short bf16_t;
typedef short bf16x8 __attribute__((ext_vector_type(8)));
typedef float f32x4 __attribute__((ext_vector_type(4)));
typedef float f32x2 __attribute__((ext_vector_type(2)));
typedef unsigned u32x4 __attribute__((ext_vector_type(4)));
typedef unsigned u32x2 __attribute__((ext_vector_type(2)));

namespace pg8 {
constexpr int BM = 256, BK = 64, HALF = 128, HTB = HALF * BK * 2, STAGE_BYTES = 8 * HTB;
__host__ __device__ __forceinline__ int lds_byte(int r, int c) { const int st = (r >> 4) * 2 + (c >> 5), rr = r & 15, cc = c & 31, ob = rr * 64 + cc * 2; return st * 1024 + (ob ^ (((ob >> 9) & 1) << 5)); }
__host__ __device__ __forceinline__ void stage_rc(int b, int& R, int& C) { const int st = b / 1024, sb = b % 1024, swz = sb ^ (((sb >> 9) & 1) << 5); R = (st >> 1) * 16 + swz / 64; C = (st & 1) * 32 + (swz % 64) / 2; }
__host__ __device__ __forceinline__ int perm32(int rho) { const int n = rho >> 4, i = rho & 15; return 8 * (i >> 2) + 4 * n + (i & 3); }
struct Unit { int pm, pn; };
struct Gemm { const bf16_t* A; const bf16_t* Bt; int K; };
struct PanelOrder {
    int nN;
    __device__ __forceinline__ bool next(int i, Unit& u) const { u.pm = 0; u.pn = i; return i < nN; }
    __device__ __forceinline__ void a_ready(const Unit&) const {}
    __device__ __forceinline__ void done(const Unit&) const {}
};
__device__ __forceinline__ float bflo_(unsigned w) { return __uint_as_float(w << 16); }
__device__ __forceinline__ float bfhi_(unsigned w) { return __uint_as_float(w & 0xffff0000u); }
__device__ __forceinline__ unsigned cvt_pk_bf16(float lo, float hi) { unsigned r; asm volatile("v_cvt_pk_bf16_f32 %0, %1, %2" : "=v"(r) : "v"(lo), "v"(hi)); return r; }

template <class Epi, class Sched>
__device__ __forceinline__ void gemm_phase(LAS unsigned char* lds, const Gemm g, const Sched& S, const Epi& E) {
    int tid = threadIdx.x; asm volatile("" : "+v"(tid));
    const int wid = __builtin_amdgcn_readfirstlane(tid >> 6), lane = tid & 63, wr = wid >> 2, wc = wid & 3, fr = lane & 15, fq = lane >> 4;
    int K = g.K; asm volatile("" : "+s"(K));
    const int nt = K / BK;
    unsigned voffA[2], voffB[2];
#pragma unroll
    for (int i = 0; i < 2; ++i) { int R, C; stage_rc(tid * 16 + i * 8192, R, C); const int Rb = Epi::PERM ? ((R & ~31) + perm32(R & 31)) : R;
        voffA[i] = (unsigned)(R * K + C) * 2u; voffB[i] = (unsigned)(Rb * K + C) * 2u; }
    const size_t kstep = (size_t)(BK * 2);
    const size_t hstep = (size_t)HALF * K * 2;
    const size_t tstep = 2 * hstep;
    const unsigned ldsw = (unsigned)wid * 1024u;
    const int aoff = lds_byte(wr * 64 + fr, fq * 8), boff = lds_byte(wc * 32 + fr, fq * 8);
#define PG8_SA(b, h) (((b) * 2 + (h)) * HTB)
#define PG8_SB(b, h) ((4 + (b) * 2 + (h)) * HTB)
#define PG8_STAGE(bufoff, gbase, voff) do { _Pragma("unroll") for (int _i = 0; _i < 2; ++_i) \
        __builtin_amdgcn_global_load_lds((const unsigned*)((const char*)(gbase) + (voff)[_i]), (LAS unsigned*)(lds + (bufoff) + ldsw + _i * 8192), 16, 0, 0); } while (0)
#define PG8_LDA(dst, b, h) do { _Pragma("unroll") for (int m = 0; m < 4; ++m) _Pragma("unroll") for (int k = 0; k < 2; ++k) dst[m][k] = *(const LAS bf16x8*)(lds + PG8_SA(b, h) + aoff + m * 2048 + k * 1024); } while (0)
#define PG8_LDB(dst, b, h) do { _Pragma("unroll") for (int n = 0; n < 2; ++n) _Pragma("unroll") for (int k = 0; k < 2; ++k) dst[n][k] = *(const LAS bf16x8*)(lds + PG8_SB(b, h) + boff + n * 2048 + k * 1024); } while (0)
#define PG8_MMA(ai, bj, At, Bt) do { __builtin_amdgcn_s_setprio(1); _Pragma("unroll") for (int m = 0; m < 4; ++m) _Pragma("unroll") for (int n = 0; n < 2; ++n) _Pragma("unroll") for (int k = 0; k < 2; ++k) \
        acc[ai][bj][m][n] = __builtin_amdgcn_mfma_f32_16x16x32_bf16(Bt[n][k], At[m][k], acc[ai][bj][m][n], 0, 0, 0); __builtin_amdgcn_s_setprio(0); } while (0)
#define PG8_WAIT_V(n) asm volatile("s_waitcnt vmcnt(" #n ")" ::: "memory")
#define PG8_WAIT_L(n) asm volatile("s_waitcnt lgkmcnt(" #n ")" ::: "memory")
#define PG8_BAR __builtin_amdgcn_s_barrier()
#define PG8_SCHED __builtin_amdgcn_sched_barrier(0)
    Unit cur, nxt; int ui = 0;
    if (!S.next(0, cur)) return;
    f32x4 acc[2][2][4][2];
#pragma unroll
    for (int a = 0; a < 2; ++a)
#pragma unroll
        for (int b = 0; b < 2; ++b)
#pragma unroll
            for (int m = 0; m < 4; ++m)
#pragma unroll
                for (int n = 0; n < 2; ++n) acc[a][b][m][n] = (f32x4){0.f, 0.f, 0.f, 0.f};
    bf16x8 At[4][2], B0[2][2], B1[2][2];
    const char* cA = (const char*)g.A + (size_t)cur.pm * tstep; const char* cB = (const char*)g.Bt + (size_t)cur.pn * tstep;
    S.a_ready(cur);
    PG8_STAGE(PG8_SB(0, 0), cB, voffB); PG8_STAGE(PG8_SB(0, 1), cB + hstep, voffB); PG8_STAGE(PG8_SA(0, 0), cA, voffA); PG8_STAGE(PG8_SA(0, 1), cA + hstep, voffA);
    if (wr == 1) PG8_BAR;
    PG8_WAIT_V(2); PG8_BAR;
    PG8_STAGE(PG8_SB(1, 0), cB + kstep, voffB); PG8_STAGE(PG8_SA(1, 0), cA + kstep, voffA); PG8_STAGE(PG8_SB(1, 1), cB + hstep + kstep, voffB);
    PG8_WAIT_V(6); PG8_BAR;
    for (;;) {
        const bool has_next = S.next(ui + 1, nxt);
        const char* nA = has_next ? (const char*)g.A + (size_t)nxt.pm * tstep : cA; const char* nB = has_next ? (const char*)g.Bt + (size_t)nxt.pn * tstep : cB;
        for (int t = 0; t < nt; t += 2) {
            const bool last = (t == nt - 2);
            const char* a1 = cA + (size_t)(t + 1) * kstep;
            const char* a2 = last ? nA : cA + (size_t)(t + 2) * kstep; const char* b2 = last ? nB : cB + (size_t)(t + 2) * kstep;
            const char* a3 = a2 + kstep; const char* b3 = b2 + kstep;
            if (last && has_next) S.a_ready(nxt);
            PG8_LDB(B0, 0, 0); PG8_LDB(B1, 0, 1); PG8_SCHED; PG8_LDA(At, 0, 0); PG8_STAGE(PG8_SA(1, 1), a1 + hstep, voffA);
            PG8_WAIT_V(8); PG8_WAIT_L(0); PG8_BAR; PG8_MMA(0, 0, At, B0); PG8_MMA(0, 1, At, B1); PG8_BAR; PG8_SCHED;
            PG8_LDA(At, 0, 1); PG8_STAGE(PG8_SB(0, 0), b2, voffB); PG8_STAGE(PG8_SB(0, 1), b2 + hstep, voffB); PG8_STAGE(PG8_SA(0, 0), a2, voffA);
            PG8_WAIT_V(8); PG8_WAIT_L(0); PG8_BAR; PG8_MMA(1, 0, At, B0); PG8_MMA(1, 1, At, B1); PG8_BAR; PG8_SCHED;
            PG8_LDB(B0, 1, 0); PG8_LDB(B1, 1, 1); PG8_SCHED; PG8_LDA(At, 1, 0); PG8_STAGE(PG8_SA(0, 1), a2 + hstep, voffA);
            PG8_WAIT_V(8); PG8_WAIT_L(0); PG8_BAR; PG8_MMA(0, 0, At, B0); PG8_MMA(0, 1, At, B1); PG8_BAR; PG8_SCHED;
            PG8_LDA(At, 1, 1); PG8_STAGE(PG8_SB(1, 0), b3, voffB); PG8_STAGE(PG8_SB(1, 1), b3 + hstep, voffB); PG8_STAGE(PG8_SA(1, 0), a3, voffA);
            PG8_WAIT_V(8); PG8_WAIT_L(0); PG8_BAR; PG8_MMA(1, 0, At, B0); PG8_MMA(1, 1, At, B1); PG8_BAR; PG8_SCHED;
        }
        if (wr == 0) PG8_BAR;
        E(acc, cur, wr, wc, fr, fq); S.done(cur);
        if (!has_next) break;
#pragma unroll
        for (int a = 0; a < 2; ++a)
#pragma unroll
            for (int b = 0; b < 2; ++b)
#pragma unroll
                for (int m = 0; m < 4; ++m)
#pragma unroll
                    for (int n = 0; n < 2; ++n) acc[a][b][m][n] = (f32x4){0.f, 0.f, 0.f, 0.f};
        cur = nxt; cA = nA; cB = nB; ++ui;
        if (wr == 1) PG8_BAR;
    }
    PG8_WAIT_V(0);
    PG8_BAR;
#undef PG8_SA
#undef PG8_SB
#undef PG8_STAGE
#undef PG8_LDA
#undef PG8_LDB
#undef PG8_MMA
#undef PG8_WAIT_V
#undef PG8_WAIT_L
#undef PG8_BAR
#undef PG8_SCHED
}

#define PG8_OPQ(p) asm volatile("" : "+v"(p))
template <int ACT  > struct EpiBf16 {
    static constexpr bool PERM = true;
    bf16_t* O; int ldc;
    __device__ __forceinline__ void operator()(const f32x4 (&acc)[2][2][4][2], const Unit& u, int wr, int wc, int fr, int fq) const {
        char* p = (char*)(O + (size_t)(wr * 64 + fr) * ldc + u.pn * BM + wc * 32 + 8 * fq);
        const size_t step = (size_t)16 * ldc * 2;
#pragma unroll
        for (int ai = 0; ai < 2; ++ai) {
#pragma unroll
            for (int m = 0; m < 4; ++m) {
                PG8_OPQ(p);
#pragma unroll
                for (int bj = 0; bj < 2; ++bj) { f32x4 v0 = acc[ai][bj][m][0], v1 = acc[ai][bj][m][1];
                    if (ACT == 1) {
#pragma unroll
                        for (int j = 0; j < 4; ++j) { const float a0 = fmaxf(v0[j], 0.f), a1 = fmaxf(v1[j], 0.f); v0[j] = a0 * a0; v1[j] = a1 * a1; } }
                    u32x4 w; w.x = cvt_pk_bf16(v0[0], v0[1]); w.y = cvt_pk_bf16(v0[2], v0[3]); w.z = cvt_pk_bf16(v1[0], v1[1]); w.w = cvt_pk_bf16(v1[2], v1[3]);
                    *(u32x4*)(p + bj * HALF * 2) = w; }
                p += step;
            }
            p += 4 * step;
        }
    }
};
struct EpiGlu {
    static constexpr bool PERM = true;
    const bf16_t* Y; int ldy; bf16_t* O; int ldc;
    __device__ __forceinline__ void operator()(const f32x4 (&acc)[2][2][4][2], const Unit& u, int wr, int wc, int fr, int fq) const {
        const int col0 = u.pn * BM + wc * 32 + 8 * fq;
        const char* py = (const char*)(Y + (size_t)(wr * 64 + fr) * ldy + col0);
        char* po = (char*)(O + (size_t)(wr * 64 + fr) * ldc + col0);
        const size_t sy = (size_t)16 * ldy * 2, so = (size_t)16 * ldc * 2;
#pragma unroll
        for (int ai = 0; ai < 2; ++ai) {
            PG8_OPQ(py); PG8_OPQ(po);
            u32x4 yv[4][2];
#pragma unroll
            for (int m = 0; m < 4; ++m)
#pragma unroll
                for (int bj = 0; bj < 2; ++bj) yv[m][bj] = *(const u32x4*)(py + m * sy + bj * HALF * 2);
            asm volatile("" ::: "memory");
#pragma unroll
            for (int m = 0; m < 4; ++m)
#pragma unroll
                for (int bj = 0; bj < 2; ++bj) { const f32x4 v0 = acc[ai][bj][m][0], v1 = acc[ai][bj][m][1]; const u32x4 y = yv[m][bj];
                    u32x4 w;
                    w.x = cvt_pk_bf16(bflo_(y.x) * __builtin_amdgcn_rcpf(1.f + __expf(-v0[0])), bfhi_(y.x) * __builtin_amdgcn_rcpf(1.f + __expf(-v0[1])));
                    w.y = cvt_pk_bf16(bflo_(y.y) * __builtin_amdgcn_rcpf(1.f + __expf(-v0[2])), bfhi_(y.y) * __builtin_amdgcn_rcpf(1.f + __expf(-v0[3])));
                    w.z = cvt_pk_bf16(bflo_(y.z) * __builtin_amdgcn_rcpf(1.f + __expf(-v1[0])), bfhi_(y.z) * __builtin_amdgcn_rcpf(1.f + __expf(-v1[1])));
                    w.w = cvt_pk_bf16(bflo_(y.w) * __builtin_amdgcn_rcpf(1.f + __expf(-v1[2])), bfhi_(y.w) * __builtin_amdgcn_rcpf(1.f + __expf(-v1[3])));
                    *(u32x4*)(po + m * so + bj * HALF * 2) = w; }
            py += 8 * sy; po += 8 * so;
        }
    }
};
struct EpiRes {
    static constexpr bool PERM = true;
    bf16_t* HB; int ldc; float alpha;
    __device__ __forceinline__ void operator()(const f32x4 (&acc)[2][2][4][2], const Unit& u, int wr, int wc, int fr, int fq) const {
        char* p = (char*)(HB + (size_t)(wr * 64 + fr) * ldc + u.pn * BM + wc * 32 + 8 * fq);
        const size_t step = (size_t)16 * ldc * 2;
#pragma unroll
        for (int ai = 0; ai < 2; ++ai) {
            PG8_OPQ(p);
            u32x4 h[4][2];
#pragma unroll
            for (int m = 0; m < 4; ++m)
#pragma unroll
                for (int bj = 0; bj < 2; ++bj) h[m][bj] = *(const u32x4*)(p + m * step + bj * HALF * 2);
#pragma unroll
            for (int m = 0; m < 4; ++m)
#pragma unroll
                for (int bj = 0; bj < 2; ++bj) { const f32x4 v0 = acc[ai][bj][m][0], v1 = acc[ai][bj][m][1]; const u32x4 hh = h[m][bj];
                    u32x4 w;
                    w.x = cvt_pk_bf16(bflo_(hh.x) * alpha + v0[0], bfhi_(hh.x) * alpha + v0[1]); w.y = cvt_pk_bf16(bflo_(hh.y) * alpha + v0[2], bfhi_(hh.y) * alpha + v0[3]);
                    w.z = cvt_pk_bf16(bflo_(hh.z) * alpha + v1[0], bfhi_(hh.z) * alpha + v1[1]); w.w = cvt_pk_bf16(bflo_(hh.w) * alpha + v1[2], bfhi_(hh.w) * alpha + v1[3]);
                    *(u32x4*)(p + m * step + bj * HALF * 2) = w; }
            p += 8 * step;
        }
    }
};
}

constexpr int M_TOK = 65536, DM = 1024, DIN = 2320, DINP = 2560, DFF = 4096, NPANEL = 256, NLAYER = 2;
constexpr int C_S5U = 0, C_Q = 256, C_K = 512, C_V = 768, C_R = 1280, C_LX = 1792, C_LG = 2048, C_GZ = 2304, NZ_MAIN = 2304;
constexpr int ZROWB = DINP * 2;
constexpr float ALPHA = 1.4142135623730951f;
constexpr float LN_EPS = 1e-5f;
constexpr size_t MiB = 1u << 20;
constexpr size_t WS_WIN = 2 * MiB, WS_WOUT = 12 * MiB, WS_W1 = 16 * MiB, WS_W2 = 32 * MiB, WS_WGLU = 48 * MiB;
constexpr size_t WS_LRUW = 48 * MiB + 512 * 1024, WS_S5A = 49 * MiB, WS_S5M = 50 * MiB, WS_S5W = 56 * MiB;
constexpr size_t WS_LRUA = 58 * MiB, WS_LRUB = 58 * MiB + 256 * 1024, WS_S5H = 59 * MiB, WS_GLAD = 61 * MiB, WS_GLAS = 64 * MiB;
constexpr size_t WS_HB = 96 * MiB, WS_PANEL = 224 * MiB, PANEL_BYTES = 2 * MiB;
constexpr size_t WS_LRUAB = 736 * MiB, WS_LRUC = 800 * MiB, WS_END = 808 * MiB;
constexpr size_t P_Z = 0, P_MIX = 1310720, P_YS5 = 1310720 + 524288, P_HID = 0;
constexpr int LDS_BYTES = 147456;
constexpr int LDS_TA = 131072, LDS_TB = 131072 + 2048, LDS_XB = 131072 + 8192;

struct Args { const float* in[30]; float* out; unsigned char* ws; };
typedef const Args __attribute__((address_space(4))) CArgs;
__device__ __forceinline__ CArgs* kargs() { CArgs* p = (CArgs*)__builtin_amdgcn_kernarg_segment_ptr(); asm volatile("" : "+s"(p)); return p; }

__device__ __forceinline__ unsigned pk2(float lo, float hi) { unsigned r; asm("v_cvt_pk_bf16_f32 %0, %1, %2" : "=v"(r) : "v"(lo), "v"(hi)); return r; }
__device__ __forceinline__ unsigned f2bf(float f) { return pk2(f, f) & 0xffffu; }
__device__ __forceinline__ float bflo(unsigned w) { return __uint_as_float(w << 16); }
__device__ __forceinline__ float bfhi(unsigned w) { return __uint_as_float(w & 0xffff0000u); }
__device__ __forceinline__ float bf1(bf16_t v) { return __uint_as_float(((unsigned)v) << 16); }
__device__ __forceinline__ float sigmoidf_(float x) { return __builtin_amdgcn_rcpf(1.f + __expf(-x)); }
__device__ __forceinline__ float gelu_tanh(float x) { const float u = 0.7978845608028654f * (x + 0.044715f * x * x * x); return x * __builtin_amdgcn_rcpf(1.f + __expf(-2.f * u)); }
__device__ __forceinline__ void lds_fence() { asm volatile("s_waitcnt lgkmcnt(0)" ::: "memory"); }
__device__ __forceinline__ void block_fence() { __builtin_amdgcn_fence(__ATOMIC_RELEASE, "workgroup"); __syncthreads(); __builtin_amdgcn_fence(__ATOMIC_ACQUIRE, "workgroup"); }
__device__ __forceinline__ float wave_sum(float v) {
#pragma unroll
    for (int o = 1; o < 64; o <<= 1) v += __shfl_xor(v, o);
    return v;
}
__device__ __forceinline__ f32x4 mfma16(bf16x8 a, bf16x8 b, f32x4 c) { return __builtin_amdgcn_mfma_f32_16x16x32_bf16(a, b, c, 0, 0, 0); }

template <bool WIN_PERM = false  >
__device__ __forceinline__ void transpose_item(const float* W, int K, int N, int Npad, bf16_t* WT, LAS float* scr, int item, int lane) {
    const int nblk = Npad / 32, kb = item / nblk, nb = item % nblk, k0 = 64 * kb, n0 = 32 * nb;
    const int nn = n0 + (lane & 31);
    const int sc = !WIN_PERM ? nn : (nn < 1792 ? nn : (nn < 2304 ? nn + 16 : nn - 512));
#pragma unroll 8
    for (int i = 0; i < 32; ++i) { const int kk = 2 * i + (lane >> 5); scr[kk * 33 + (lane & 31)] = (nn < N) ? W[(size_t)(k0 + kk) * N + sc] : 0.f; }
    lds_fence();
    const int c = lane & 7;
#pragma unroll
    for (int j = 0; j < 4; ++j) { const int n = (lane >> 3) + 8 * j; const LAS float* s = scr + (8 * c) * 33 + n;
        u32x4 o; o.x = pk2(s[0 * 33], s[1 * 33]); o.y = pk2(s[2 * 33], s[3 * 33]); o.z = pk2(s[4 * 33], s[5 * 33]); o.w = pk2(s[6 * 33], s[7 * 33]);
        *(u32x4*)(WT + (size_t)(n0 + n) * K + k0 + 8 * c) = o; }
    lds_fence();
}
__device__ __forceinline__ void s5_pow(float lrdt, float rev1, float n, float& pr, float& pi) {
    const float mag = __expf(n * lrdt);
    const float r = n * rev1, rr = __builtin_fmaf(n, rev1, -r);
    const float fr_ = (r - rintf(r)) + rr;
    pr = mag * __builtin_amdgcn_cosf(fr_); pi = mag * __builtin_amdgcn_sinf(fr_);
}
struct S5Lane { float lrdt, rev1, fre, fim; };
__device__ __forceinline__ S5Lane s5_lane(CArgs& a, int l, int g, int p) {
    S5Lane s;
    const float dt = expf(a.in[6][l * 16 + g]);
    const float lr = fminf(a.in[4][(l * 16 + g) * 64 + p], -1e-4f), li = a.in[5][(l * 16 + g) * 64 + p];
    s.lrdt = lr * dt; const float ang = li * dt; s.rev1 = ang * 0.15915494309189535f;
    float ar, ai; s5_pow(s.lrdt, s.rev1, 1.f, ar, ai);
    const float den = lr * lr + li * li;
    s.fre = ((ar - 1.f) * lr + ai * li) / den; s.fim = (ai * lr - (ar - 1.f) * li) / den;
    return s;
}
__device__ __forceinline__ void s5_prep_k(CArgs& a, unsigned char* ws, LAS float* scr, int l, int g, int d, int lane) {
    const int p = lane; const S5Lane s = s5_lane(a, l, g, p);
    float pr, pi; s5_pow(s.lrdt, s.rev1, (float)d, pr, pi);
    const float* bre = a.in[7] + ((size_t)(l * 16 + g) * 64 + p) * 16; const float* bim = a.in[8] + ((size_t)(l * 16 + g) * 64 + p) * 16;
    const float* cre = a.in[9] + (size_t)(l * 16 + g) * 16 * 64 + p; const float* cim = a.in[10] + (size_t)(l * 16 + g) * 16 * 64 + p;
    for (int c = 0; c < 16; ++c) {
        const float cr = cre[c * 64], ci = cim[c * 64];
        scr[(0 * 16 + c) * 65 + p] = cr * pr - ci * pi; scr[(1 * 16 + c) * 65 + p] = cr * pi + ci * pr;
        const float br = bre[c], bi = bim[c];
        scr[(2 * 16 + c) * 65 + p] = s.fre * br - s.fim * bi; scr[(3 * 16 + c) * 65 + p] = s.fre * bi + s.fim * br;
    }
    lds_fence();
    bf16_t* Mg = (bf16_t*)(ws + WS_S5M) + (size_t)(l * 16 + g) * 64 * 192;
    for (int q = 0; q < 4; ++q) {
        const int idx = lane + 64 * q, co = idx >> 4, ci = idx & 15;
        float v = 0.f;
        for (int pp = 0; pp < 64; ++pp) v += scr[(0 * 16 + co) * 65 + pp] * scr[(2 * 16 + ci) * 65 + pp] - scr[(1 * 16 + co) * 65 + pp] * scr[(3 * 16 + ci) * 65 + pp];
        const bf16_t vb = (bf16_t)f2bf(v);
        for (int to = d; to < 4; ++to) {
            Mg[(size_t)(to * 16 + co) * 192 + (to - d) * 16 + ci] = vb;
            if (d > 0) Mg[(size_t)((to - d) * 16 + co) * 192 + to * 16 + ci] = 0;
        }
    }
    lds_fence();
}
__device__ __forceinline__ void s5_prep_vw(CArgs& a, unsigned char* ws, int l, int g, int lane) {
    const int p = lane; const S5Lane s = s5_lane(a, l, g, p);
    float* A = (float*)(ws + WS_S5A) + ((size_t)(l * 16 + g) * 64 + p) * 4;
    { float r4, i4, r256, i256; s5_pow(s.lrdt, s.rev1, 4.f, r4, i4); s5_pow(s.lrdt, s.rev1, 256.f, r256, i256); A[0] = r4; A[1] = i4; A[2] = r256; A[3] = i256; }
    const float* bre = a.in[7] + ((size_t)(l * 16 + g) * 64 + p) * 16; const float* bim = a.in[8] + ((size_t)(l * 16 + g) * 64 + p) * 16;
    const float* cre = a.in[9] + (size_t)(l * 16 + g) * 16 * 64 + p; const float* cim = a.in[10] + (size_t)(l * 16 + g) * 16 * 64 + p;
    bf16_t* Wg = (bf16_t*)(ws + WS_S5W) + (size_t)(l * 16 + g) * 128 * 64;
    bf16_t* Mg = (bf16_t*)(ws + WS_S5M) + (size_t)(l * 16 + g) * 64 * 192;
    float bbr[16], bbi[16], cr[16], ci[16];
#pragma unroll
    for (int c = 0; c < 16; ++c) { const float br = bre[c], bi = bim[c]; bbr[c] = s.fre * br - s.fim * bi; bbi[c] = s.fre * bi + s.fim * br; cr[c] = cre[c * 64]; ci[c] = cim[c * 64]; }
#pragma unroll 1
    for (int t = 0; t < 4; ++t) {
        float pr, pi; s5_pow(s.lrdt, s.rev1, (float)(3 - t), pr, pi);
        float qr, qi; s5_pow(s.lrdt, s.rev1, (float)(t + 1), qr, qi);
#pragma unroll
        for (int c = 0; c < 16; c += 2) {
            *(unsigned*)(Wg + (size_t)(2 * p) * 64 + t * 16 + c) = pk2(pr * bbr[c] - pi * bbi[c], pr * bbr[c + 1] - pi * bbi[c + 1]);
            *(unsigned*)(Wg + (size_t)(2 * p + 1) * 64 + t * 16 + c) = pk2(pr * bbi[c] + pi * bbr[c], pr * bbi[c + 1] + pi * bbr[c + 1]);
        }
#pragma unroll
        for (int c = 0; c < 16; ++c) {
            const float vr = cr[c] * qr - ci[c] * qi, vi = cr[c] * qi + ci[c] * qr;
            *(unsigned*)(Mg + (size_t)(t * 16 + c) * 192 + 64 + 2 * p) = pk2(vr, -vi);
        }
    }
}
__device__ __forceinline__ void ln_panel(const float* src, float* dst, bf16_t* dstb, const float* gam, const float* bet, LAS f32x2* T) {
    int tid_ = threadIdx.x; asm volatile("" : "+v"(tid_));
    const int lane = tid_ & 63, wave = __builtin_amdgcn_readfirstlane(tid_ >> 6);
    constexpr int NB = 2;
    f32x4 cur[NB][4], nxt[NB][4];
    const int r0 = wave * 32;
#pragma unroll
    for (int b = 0; b < NB; ++b)
#pragma unroll
        for (int j = 0; j < 4; ++j) cur[b][j] = ((const f32x4*)(src + (size_t)(r0 + b) * DM))[lane + 64 * j];
    f32x4 gv[4], bv[4];
#pragma unroll
    for (int j = 0; j < 4; ++j) { gv[j] = ((const f32x4*)gam)[lane + 64 * j]; bv[j] = ((const f32x4*)bet)[lane + 64 * j]; }
    for (int it = 0; it < 32 / NB; ++it) {
        const int r = r0 + it * NB;
        if (it + 1 < 32 / NB) {
#pragma unroll
            for (int b = 0; b < NB; ++b)
#pragma unroll
                for (int j = 0; j < 4; ++j) nxt[b][j] = ((const f32x4*)(src + (size_t)(r + NB + b) * DM))[lane + 64 * j];
        }
        float s[NB], s2[NB];
#pragma unroll
        for (int b = 0; b < NB; ++b) { s[b] = 0.f;
#pragma unroll
            for (int j = 0; j < 4; ++j) s[b] += (cur[b][j].x + cur[b][j].y) + (cur[b][j].z + cur[b][j].w); }
#pragma unroll
        for (int o = 1; o < 64; o <<= 1)
#pragma unroll
            for (int b = 0; b < NB; ++b) s[b] += __shfl_xor(s[b], o);
#pragma unroll
        for (int b = 0; b < NB; ++b) { const float mean = s[b] * (1.f / DM); s2[b] = 0.f;
#pragma unroll
            for (int j = 0; j < 4; ++j) { cur[b][j] = cur[b][j] - mean; s2[b] += (cur[b][j].x * cur[b][j].x + cur[b][j].y * cur[b][j].y) + (cur[b][j].z * cur[b][j].z + cur[b][j].w * cur[b][j].w); } }
#pragma unroll
        for (int o = 1; o < 64; o <<= 1)
#pragma unroll
            for (int b = 0; b < NB; ++b) s2[b] += __shfl_xor(s2[b], o);
#pragma unroll
        for (int b = 0; b < NB; ++b) {
            const float rstd = 1.f / sqrtf(s2[b] * (1.f / DM) + LN_EPS);
            if (T && lane == 0) T[r + b] = (f32x2){s[b] * (1.f / DM), rstd};
#pragma unroll
            for (int j = 0; j < 4; ++j) {
                const f32x4 o = cur[b][j] * rstd * gv[j] + bv[j];
                if (dst) ((f32x4*)(dst + (size_t)(r + b) * DM))[lane + 64 * j] = o;
                if (dstb) { u32x2 w; w.x = pk2(o.x, o.y); w.y = pk2(o.z, o.w); ((u32x2*)(dstb + (size_t)(r + b) * DM))[lane + 64 * j] = w; }
            }
        }
#pragma unroll
        for (int b = 0; b < NB; ++b)
#pragma unroll
            for (int j = 0; j < 4; ++j) cur[b][j] = nxt[b][j];
    }
}

__device__ __forceinline__ void ln_panel_b(bf16_t* hb, float* outf, const float* gam, const float* bet) {
    int tid_ = threadIdx.x; asm volatile("" : "+v"(tid_));
    const int lane = tid_ & 63, wave = __builtin_amdgcn_readfirstlane(tid_ >> 6);
    constexpr int NB = 2;
    u32x4 nxt[NB][2];
    const int r0 = wave * 32;
#pragma unroll
    for (int b = 0; b < NB; ++b)
#pragma unroll
        for (int j = 0; j < 2; ++j) nxt[b][j] = ((const u32x4*)(hb + (size_t)(r0 + b) * DM))[lane + 64 * j];
    f32x4 gv[2][2], bv[2][2];
#pragma unroll
    for (int j = 0; j < 2; ++j)
#pragma unroll
        for (int q = 0; q < 2; ++q) { gv[j][q] = *(const f32x4*)(gam + 512 * j + 8 * lane + 4 * q); bv[j][q] = *(const f32x4*)(bet + 512 * j + 8 * lane + 4 * q); }
    for (int it = 0; it < 32 / NB; ++it) {
        const int r = r0 + it * NB;
        float v[NB][16];
#pragma unroll
        for (int b = 0; b < NB; ++b)
#pragma unroll
            for (int j = 0; j < 2; ++j)
#pragma unroll
                for (int k = 0; k < 4; ++k) { v[b][8 * j + 2 * k] = bflo(nxt[b][j][k]); v[b][8 * j + 2 * k + 1] = bfhi(nxt[b][j][k]); }
        if (it + 1 < 32 / NB) {
#pragma unroll
            for (int b = 0; b < NB; ++b)
#pragma unroll
                for (int j = 0; j < 2; ++j) nxt[b][j] = ((const u32x4*)(hb + (size_t)(r + NB + b) * DM))[lane + 64 * j];
        }
        float s[NB], s2[NB];
#pragma unroll
        for (int b = 0; b < NB; ++b) { s[b] = 0.f;
#pragma unroll
            for (int k = 0; k < 16; ++k) s[b] += v[b][k]; }
#pragma unroll
        for (int o = 1; o < 64; o <<= 1)
#pragma unroll
            for (int b = 0; b < NB; ++b) s[b] += __shfl_xor(s[b], o);
#pragma unroll
        for (int b = 0; b < NB; ++b) { const float mean = s[b] * (1.f / DM); s2[b] = 0.f;
#pragma unroll
            for (int k = 0; k < 16; ++k) { v[b][k] -= mean; s2[b] += v[b][k] * v[b][k]; } }
#pragma unroll
        for (int o = 1; o < 64; o <<= 1)
#pragma unroll
            for (int b = 0; b < NB; ++b) s2[b] += __shfl_xor(s2[b], o);
#pragma unroll
        for (int b = 0; b < NB; ++b) {
            const float rstd = 1.f / sqrtf(s2[b] * (1.f / DM) + LN_EPS);
#pragma unroll
            for (int j = 0; j < 2; ++j) {
                float o[8];
#pragma unroll
                for (int k = 0; k < 8; ++k) o[k] = v[b][8 * j + k] * rstd * gv[j][k >> 2][k & 3] + bv[j][k >> 2][k & 3];
                if (outf) { f32x4* op = (f32x4*)(outf + (size_t)(r + b) * DM + 512 * j + 8 * lane); op[0] = (f32x4){o[0], o[1], o[2], o[3]}; op[1] = (f32x4){o[4], o[5], o[6], o[7]}; }
                else { u32x4 w; w.x = pk2(o[0], o[1]); w.y = pk2(o[2], o[3]); w.z = pk2(o[4], o[5]); w.w = pk2(o[6], o[7]); ((u32x4*)(hb + (size_t)(r + b) * DM))[lane + 64 * j] = w; }
            }
        }
    }
}

__device__ __forceinline__ void prologue(CArgs& a, LAS unsigned char* lds, int panel, int G) {
    int tid_ = threadIdx.x; asm volatile("" : "+v"(tid_));
    const int lane = tid_ & 63, wave = __builtin_amdgcn_readfirstlane(tid_ >> 6);
    unsigned char* ws = a.ws;
    LAS float* scr = (LAS float*)(lds + wave * 17408);
    const int gw = panel * 8 + wave, NGW = G * 8;
    constexpr int I_IN = (DM / 64) * (DINP / 32), I_OUT = (DM / 64) * (DM / 32), I_1 = (DM / 64) * (DFF / 32), I_2 = (DFF / 64) * (DM / 32), I_G = (256 / 64) * (256 / 32);
    constexpr int I_L = I_IN + I_OUT + I_1 + I_2 + I_G;
    for (int it = gw; it < NLAYER * I_L; it += NGW) {
        const int l = it / I_L; int r = it % I_L;
        if (r < I_IN) { transpose_item<true>(a.in[3] + (size_t)l * DM * DIN, DM, DIN, DINP, (bf16_t*)(ws + WS_WIN) + (size_t)l * DINP * DM, scr, r, lane); continue; } r -= I_IN;
        if (r < I_OUT) { transpose_item(a.in[23] + (size_t)l * DM * DM, DM, DM, DM, (bf16_t*)(ws + WS_WOUT) + (size_t)l * DM * DM, scr, r, lane); continue; } r -= I_OUT;
        if (r < I_1) { transpose_item(a.in[26] + (size_t)l * DM * DFF, DM, DFF, DFF, (bf16_t*)(ws + WS_W1) + (size_t)l * DFF * DM, scr, r, lane); continue; } r -= I_1;
        if (r < I_2) { transpose_item(a.in[27] + (size_t)l * DFF * DM, DFF, DM, DM, (bf16_t*)(ws + WS_W2) + (size_t)l * DM * DFF, scr, r, lane); continue; } r -= I_2;
        transpose_item(a.in[12] + (size_t)l * 256 * 256, 256, 256, 256, (bf16_t*)(ws + WS_WGLU) + (size_t)l * 256 * 256, scr, r, lane);
    }
    for (int it = NGW - 1 - gw; it < NLAYER * 16 * 5; it += NGW) {
        const int l = it / (16 * 5), r = it % (16 * 5), g = r / 5, d = r % 5;
        if (d < 4) s5_prep_k(a, ws, scr, l, g, d, lane); else s5_prep_vw(a, ws, l, g, lane);
    }
    for (int e = gw * 64 + lane; e < NLAYER * 2 * 8 * 1024; e += NGW * 64) {
        const int i = e & 31, j = (e >> 5) & 31, h = (e >> 10) & 7, which = (e >> 13) & 1, l = e >> 14;
        const float* w = a.in[which ? 20 : 18] + (size_t)(l * 8 + h) * 1024;
        ((bf16_t*)(ws + WS_LRUW))[e] = (bf16_t)f2bf(w[i * 32 + j]);
    }
    __syncthreads();
    ln_panel(a.in[0] + (size_t)panel * 256 * DM, nullptr, (bf16_t*)(ws + WS_HB) + (size_t)panel * 256 * DM, a.in[1], a.in[2], nullptr);
}

__device__ __forceinline__ void gz_phase(CArgs& a, int l, int panel) {
    int tid_ = threadIdx.x; asm volatile("" : "+v"(tid_));
    const int lane = tid_ & 63, wave = __builtin_amdgcn_readfirstlane(tid_ >> 6), fr = lane & 15, fq = lane >> 4;
    unsigned char* ws = a.ws;
    const bf16_t* Hb = (const bf16_t*)(ws + WS_HB) + (size_t)panel * 256 * DM + (size_t)(wave * 32 + fr) * DM + 8 * fq;
    const bf16_t* Wt = (const bf16_t*)(ws + WS_WIN) + (size_t)l * DINP * DM + (size_t)(C_GZ + fr) * DM + 8 * fq;
    f32x4 acc0 = (f32x4){0.f, 0.f, 0.f, 0.f}, acc1 = acc0;
#pragma unroll 8
    for (int ks = 0; ks < 32; ++ks) {
        const bf16x8 wf = *(const bf16x8*)(Wt + 32 * ks);
        acc0 = mfma16(wf, *(const bf16x8*)(Hb + 32 * ks), acc0);
        acc1 = mfma16(wf, *(const bf16x8*)(Hb + 16 * DM + 32 * ks), acc1);
    }
    unsigned char* Zp = ws + WS_PANEL + (size_t)panel * PANEL_BYTES + P_Z;
    u32x2 w0, w1; w0.x = pk2(acc0[0], acc0[1]); w0.y = pk2(acc0[2], acc0[3]); w1.x = pk2(acc1[0], acc1[1]); w1.y = pk2(acc1[2], acc1[3]);
    *(u32x2*)(Zp + (size_t)(wave * 32 + fr) * ZROWB + (C_GZ + 4 * fq) * 2) = w0;
    *(u32x2*)(Zp + (size_t)(wave * 32 + 16 + fr) * ZROWB + (C_GZ + 4 * fq) * 2) = w1;
}

template <int PASS>
__device__ __forceinline__ void lru_pass(CArgs& a, int l, int panel) {
    int tid_ = threadIdx.x; asm volatile("" : "+v"(tid_));
    const int lane = tid_ & 63, wave = tid_ >> 6;
    unsigned char* ws = a.ws;
    const int fr = lane & 15, fq = lane >> 4, h = wave, ch0 = h * 32 + 8 * fq;
    float cw[4][8], cb[8], br[8], bi[8], sp[8];
#pragma unroll
    for (int c = 0; c < 8; ++c) {
#pragma unroll
        for (int j = 0; j < 4; ++j) cw[j][c] = a.in[16][(size_t)(l * 4 + j) * 256 + ch0 + c];
        cb[c] = a.in[17][l * 256 + ch0 + c]; br[c] = a.in[19][l * 256 + ch0 + c]; bi[c] = a.in[21][l * 256 + ch0 + c];
        const float x = -a.in[22][l * 256 + ch0 + c];
        sp[c] = 8.f * (fmaxf(x, 0.f) + log1pf(expf(-fabsf(x))));
    }
    bf16x8 wrf[2], wif[2];
#pragma unroll
    for (int mt = 0; mt < 2; ++mt) { const int j = 8 * (fr >> 2) + 4 * mt + (fr & 3);
        wrf[mt] = *(const bf16x8*)((const bf16_t*)(ws + WS_LRUW) + (size_t)((l * 2 + 0) * 8 + h) * 1024 + j * 32 + 8 * fq);
        wif[mt] = *(const bf16x8*)((const bf16_t*)(ws + WS_LRUW) + (size_t)((l * 2 + 1) * 8 + h) * 1024 + j * 32 + 8 * fq); }
    const unsigned char* Zp = ws + WS_PANEL + (size_t)panel * PANEL_BYTES + P_Z;
    const unsigned char* Zprev = Zp - PANEL_BYTES;
    unsigned char* MIX = ws + WS_PANEL + (size_t)panel * PANEL_BYTES + P_MIX;
    const bool seq_start = (panel & 31) == 0;
    float hin[8], atot[8];
#pragma unroll
    for (int c = 0; c < 8; ++c) { hin[c] = (PASS == 2) ? ((const float*)(ws + WS_LRUB))[(size_t)panel * 256 + ch0 + c] : 0.f; atot[c] = 1.f; }
    u32x4 xn[4], gn = (u32x4){0u, 0u, 0u, 0u};
#define LRU_LOAD(tile_) do { const int t_ = (tile_) * 16 + fr; _Pragma("unroll") for (int j = 0; j < 4; ++j) { const int tt = t_ - 3 + j; xn[j] = (u32x4){0u, 0u, 0u, 0u}; \
            if (tt >= 0) xn[j] = *(const u32x4*)(Zp + (size_t)tt * ZROWB + (C_LX + ch0) * 2); \
            else if (!seq_start) xn[j] = *(const u32x4*)(Zprev + (size_t)(256 + tt) * ZROWB + (C_LX + ch0) * 2); } \
        if (PASS == 2) gn = *(const u32x4*)(Zp + (size_t)t_ * ZROWB + (C_LG + ch0) * 2); } while (0)
    LRU_LOAD(0);
    for (int tile = 0; tile < 16; ++tile) {
        const int t = tile * 16 + fr;
        float xc[8];
#pragma unroll
        for (int c = 0; c < 8; ++c) xc[c] = cb[c];
#pragma unroll
        for (int j = 0; j < 4; ++j) {
            const u32x4 xv = xn[j];
#pragma unroll
            for (int k = 0; k < 4; ++k) { xc[2 * k] += cw[j][2 * k] * bflo(xv[k]); xc[2 * k + 1] += cw[j][2 * k + 1] * bfhi(xv[k]); }
        }
        const u32x4 gv = gn;
        if (tile + 1 < 16) LRU_LOAD(tile + 1);
        u32x4 xp; xp.x = pk2(xc[0], xc[1]); xp.y = pk2(xc[2], xc[3]); xp.z = pk2(xc[4], xc[5]); xp.w = pk2(xc[6], xc[7]);
        const bf16x8 xcb = __builtin_bit_cast(bf16x8, xp);
        f32x4 ar[2], ai[2];
#pragma unroll
        for (int mt = 0; mt < 2; ++mt) { ar[mt] = mfma16(wrf[mt], xcb, (f32x4){0.f, 0.f, 0.f, 0.f}); ai[mt] = mfma16(wif[mt], xcb, (f32x4){0.f, 0.f, 0.f, 0.f}); }
        float A[8], B[8];
#pragma unroll
        for (int c = 0; c < 8; ++c) {
            const float gr = sigmoidf_(ar[c >> 2][c & 3] + br[c]), gi = sigmoidf_(ai[c >> 2][c & 3] + bi[c]);
            const float la = -gr * sp[c];
            const float x2 = 2.f * la;
            const float om = -x2 * (1.f + x2 * (0.5f + x2 * (0.16666667f + x2 * (0.041666668f + x2 * (0.0083333338f + x2 * 0.0013888889f)))));
            A[c] = __expf(la); B[c] = __builtin_amdgcn_sqrtf(fmaxf(om, 0.f)) * (gi * xc[c]);
        }
#pragma unroll
        for (int s = 1; s < 16; s <<= 1) {
#pragma unroll
            for (int c = 0; c < 8; ++c) { const float ap = __shfl_up(A[c], s, 16), bp = __shfl_up(B[c], s, 16);
                if (fr >= s) { B[c] = A[c] * bp + B[c]; A[c] = A[c] * ap; } }
        }
        if (PASS == 2) {
            float o[8];
#pragma unroll
            for (int k = 0; k < 4; ++k) { o[2 * k] = (A[2 * k] * hin[2 * k] + B[2 * k]) * gelu_tanh(bflo(gv[k])); o[2 * k + 1] = (A[2 * k + 1] * hin[2 * k + 1] + B[2 * k + 1]) * gelu_tanh(bfhi(gv[k])); }
            u32x4 w; w.x = pk2(o[0], o[1]); w.y = pk2(o[2], o[3]); w.z = pk2(o[4], o[5]); w.w = pk2(o[6], o[7]);
            *(u32x4*)(MIX + (size_t)t * 2048 + (768 + ch0) * 2) = w;
        }
        if (PASS == 1) {
            u32x4 w0, w1; w0.x = pk2(A[0], B[0]); w0.y = pk2(A[1], B[1]); w0.z = pk2(A[2], B[2]); w0.w = pk2(A[3], B[3]); w1.x = pk2(A[4], B[4]); w1.y = pk2(A[5], B[5]); w1.z = pk2(A[6], B[6]); w1.w = pk2(A[7], B[7]);
            u32x4* abp = (u32x4*)(ws + WS_LRUAB + (((size_t)panel * 256 + t) * 256 + ch0) * 4); abp[0] = w0; abp[1] = w1;
        }
        float a15[8], b15[8];
#pragma unroll
        for (int c = 0; c < 8; ++c) { a15[c] = __shfl(A[c], 15, 16); b15[c] = __shfl(B[c], 15, 16); hin[c] = a15[c] * hin[c] + b15[c]; atot[c] *= a15[c]; }
        if (PASS == 1 && fr == 0) {
            f32x4* cp = (f32x4*)(ws + WS_LRUC + (((size_t)panel * 16 + tile) * 256 + ch0) * 8);
            cp[0] = (f32x4){a15[0], b15[0], a15[1], b15[1]}; cp[1] = (f32x4){a15[2], b15[2], a15[3], b15[3]}; cp[2] = (f32x4){a15[4], b15[4], a15[5], b15[5]}; cp[3] = (f32x4){a15[6], b15[6], a15[7], b15[7]};
        }
    }
    if (PASS == 1 && fr == 0) {
#pragma unroll
        for (int c = 0; c < 8; ++c) { ((float*)(ws + WS_LRUA))[(size_t)panel * 256 + ch0 + c] = atot[c]; ((float*)(ws + WS_LRUB))[(size_t)panel * 256 + ch0 + c] = hin[c]; }
    }
}

__device__ __forceinline__ void lru_apply(CArgs& a, int l, int panel) {
    int tid_ = threadIdx.x; asm volatile("" : "+v"(tid_));
    const int lane = tid_ & 63, wave = tid_ >> 6;
    unsigned char* ws = a.ws;
    const int fr = lane & 15, fq = lane >> 4, ch0 = wave * 32 + 8 * fq;
    const unsigned char* Zp = ws + WS_PANEL + (size_t)panel * PANEL_BYTES + P_Z;
    unsigned char* MIX = ws + WS_PANEL + (size_t)panel * PANEL_BYTES + P_MIX;
    float hin[8];
#pragma unroll
    for (int c = 0; c < 8; ++c) hin[c] = ((const float*)(ws + WS_LRUB))[(size_t)panel * 256 + ch0 + c];
    u32x4 abn[2], gn; f32x4 cn[4];
#define LRU2_LOAD(tile_) do { const int t_ = (tile_) * 16 + fr; const u32x4* abp_ = (const u32x4*)(ws + WS_LRUAB + (((size_t)panel * 256 + t_) * 256 + ch0) * 4); abn[0] = abp_[0]; abn[1] = abp_[1]; \
        gn = *(const u32x4*)(Zp + (size_t)t_ * ZROWB + (C_LG + ch0) * 2); \
        const f32x4* cp_ = (const f32x4*)(ws + WS_LRUC + (((size_t)panel * 16 + (tile_)) * 256 + ch0) * 8); cn[0] = cp_[0]; cn[1] = cp_[1]; cn[2] = cp_[2]; cn[3] = cp_[3]; } while (0)
    LRU2_LOAD(0);
    for (int tile = 0; tile < 16; ++tile) {
        const int t = tile * 16 + fr;
        const u32x4 ab0 = abn[0], ab1 = abn[1], gv = gn; const f32x4 c0 = cn[0], c1 = cn[1], c2 = cn[2], c3 = cn[3];
        if (tile + 1 < 16) LRU2_LOAD(tile + 1);
        float o[8];
#pragma unroll
        for (int k = 0; k < 4; ++k) {
            o[k] = bflo(ab0[k]) * hin[k] + bfhi(ab0[k]); o[4 + k] = bflo(ab1[k]) * hin[4 + k] + bfhi(ab1[k]);
        }
#pragma unroll
        for (int k = 0; k < 4; ++k) { o[2 * k] *= gelu_tanh(bflo(gv[k])); o[2 * k + 1] *= gelu_tanh(bfhi(gv[k])); }
        u32x4 w; w.x = pk2(o[0], o[1]); w.y = pk2(o[2], o[3]); w.z = pk2(o[4], o[5]); w.w = pk2(o[6], o[7]);
        *(u32x4*)(MIX + (size_t)t * 2048 + (768 + ch0) * 2) = w;
        hin[0] = c0[0] * hin[0] + c0[1]; hin[1] = c0[2] * hin[1] + c0[3]; hin[2] = c1[0] * hin[2] + c1[1]; hin[3] = c1[2] * hin[3] + c1[3];
        hin[4] = c2[0] * hin[4] + c2[1]; hin[5] = c2[2] * hin[5] + c2[3]; hin[6] = c3[0] * hin[6] + c3[1]; hin[7] = c3[2] * hin[7] + c3[3];
    }
#undef LRU2_LOAD
}

template <int PASS>
__device__ __forceinline__ void s5_pass(CArgs& a, LAS unsigned char* lds, int l, int panel) {
    int tid_ = threadIdx.x; asm volatile("" : "+v"(tid_));
    const int lane = tid_ & 63, wave = __builtin_amdgcn_readfirstlane(tid_ >> 6);
    unsigned char* ws = a.ws;
    const int fr = lane & 15, fq = lane >> 4;
    LAS float* hl = (LAS float*)(lds + wave * 12288);
    LAS bf16_t* xh = (LAS bf16_t*)(lds + wave * 12288 + 8192);
    const unsigned char* Zp = ws + WS_PANEL + (size_t)panel * PANEL_BYTES + P_Z;
    unsigned char* YS5 = ws + WS_PANEL + (size_t)panel * PANEL_BYTES + P_YS5;
    for (int gi = 0; gi < 2; ++gi) {
        const int g = 2 * wave + gi;
        const bf16_t* Wg = (const bf16_t*)(ws + WS_S5W) + (size_t)(l * 16 + g) * 128 * 64;
        const bf16_t* Mg = (const bf16_t*)(ws + WS_S5M) + (size_t)(l * 16 + g) * 64 * 192;
        bf16x8 wf[8][2];
#pragma unroll
        for (int mt = 0; mt < 8; ++mt)
#pragma unroll
            for (int ks = 0; ks < 2; ++ks) wf[mt][ks] = *(const bf16x8*)(Wg + (size_t)(16 * mt + fr) * 64 + 32 * ks + 8 * fq);
        bf16x8 mf[4][4];
        f32x4 dsk = (f32x4){0.f, 0.f, 0.f, 0.f};
        if (PASS == 2) {
#pragma unroll
            for (int mt = 0; mt < 4; ++mt)
#pragma unroll
                for (int ks = 0; ks < 4; ++ks) mf[mt][ks] = *(const bf16x8*)(Mg + (size_t)(16 * mt + fr) * 192 + 64 + 32 * ks + 8 * fq);
            dsk = *(const f32x4*)(a.in[11] + l * 256 + g * 16 + 4 * fq);
        }
        const float* Ap = (const float*)(ws + WS_S5A) + ((size_t)(l * 16 + g) * 64 + lane) * 4;
        const float a4r = Ap[0], a4i = Ap[1];
        float* Hg = (float*)(ws + WS_S5H) + ((size_t)panel * 16 + g) * 128 + 2 * lane;
        float Hr = 0.f, Hi = 0.f;
        if (PASS == 2) { Hr = Hg[0]; Hi = Hg[1]; }
#pragma unroll 1
        for (int nt = 0; nt < 4; ++nt) {
            bf16x8 xf[2];
#pragma unroll
            for (int ks = 0; ks < 2; ++ks) xf[ks] = *(const bf16x8*)(Zp + (size_t)(64 * nt + 4 * fr + 2 * ks + (fq >> 1)) * ZROWB + (C_S5U + g * 16 + (fq & 1) * 8) * 2);
#pragma unroll
            for (int mt = 0; mt < 8; ++mt) {
                f32x4 acc = mfma16(wf[mt][0], xf[0], (f32x4){0.f, 0.f, 0.f, 0.f});
                acc = mfma16(wf[mt][1], xf[1], acc);
                *(LAS f32x4*)(hl + fr * 128 + 16 * mt + 4 * fq) = acc;
            }
            lds_fence();
            for (int j = 0; j < 16; ++j) {
                if (PASS == 2) *(LAS unsigned*)(xh + j * 128 + 2 * lane) = pk2(Hr, Hi);
                const f32x2 lc = *(LAS f32x2*)(hl + j * 128 + 2 * lane);
                const float nr = a4r * Hr - a4i * Hi + lc.x, ni = a4r * Hi + a4i * Hr + lc.y;
                Hr = nr; Hi = ni;
            }
            lds_fence();
            if (PASS == 2) {
                bf16x8 xhf[4];
#pragma unroll
                for (int k4 = 0; k4 < 4; ++k4) xhf[k4] = *(const LAS bf16x8*)(xh + fr * 128 + 32 * k4 + 8 * fq);
#pragma unroll
                for (int mt = 0; mt < 4; ++mt) {
                    f32x4 acc = (f32x4){0.f, 0.f, 0.f, 0.f};
#pragma unroll
                    for (int ks = 0; ks < 2; ++ks) if (2 * ks <= mt) acc = mfma16(*(const bf16x8*)(Mg + (size_t)(16 * mt + fr) * 192 + 32 * ks + 8 * fq), xf[ks], acc);
#pragma unroll
                    for (int k4 = 0; k4 < 4; ++k4) acc = mfma16(mf[mt][k4], xhf[k4], acc);
                    const int tok = (16 * nt + fr) * 4 + mt, ch = g * 16 + 4 * fq;
                    const u32x2 uv = *(const u32x2*)(Zp + (size_t)tok * ZROWB + (C_S5U + ch) * 2);
                    const float y0 = gelu_tanh(acc[0] + dsk[0] * bflo(uv.x)), y1 = gelu_tanh(acc[1] + dsk[1] * bfhi(uv.x));
                    const float y2 = gelu_tanh(acc[2] + dsk[2] * bflo(uv.y)), y3 = gelu_tanh(acc[3] + dsk[3] * bfhi(uv.y));
                    u32x2 w; w.x = pk2(y0, y1); w.y = pk2(y2, y3);
                    *(u32x2*)(YS5 + (size_t)tok * 512 + ch * 2) = w;
                }
            }
            lds_fence();
        }
        if (PASS == 1) { Hg[0] = Hr; Hg[1] = Hi; }
    }
}

constexpr int GL_QE = 0, GL_KE = 9216, GL_KDT = 18432, GL_VT = 27648, GL_SC = 46080, GL_ST = 55296, GL_GP = 73728, GL_SS = 75776, GL_DK = 76288, GL_X = 77824;
constexpr int GXS = 68;
constexpr int GRS = 144;
template <int PASS>
__device__ __forceinline__ void gla_pass(CArgs& a, LAS unsigned char* lds, int l, int panel) {
    int tid = threadIdx.x; asm volatile("" : "+v"(tid));
    const int lane = tid & 63, wave = tid >> 6;
    unsigned char* ws = a.ws;
    const int fr = lane & 15, fq = lane >> 4;
    const int d_ = lane, tq = wave;
    const int e_ = tid & 127, tq4 = tid >> 7;
    const int wq = wave & 3, wh = wave >> 2;
    const unsigned char* Zp = ws + WS_PANEL + (size_t)panel * PANEL_BYTES + P_Z;
    unsigned char* MIX = ws + WS_PANEL + (size_t)panel * PANEL_BYTES + P_MIX;
    LAS float* GP = (LAS float*)(lds + GL_GP); LAS float* SS = (LAS float*)(lds + GL_SS); LAS float* DK = (LAS float*)(lds + GL_DK);
    u32x4 pgz[2]; bf16_t pq[8], pk[8]; unsigned pv[8]; u32x2 pr[4];
#define GLA_LOAD(it_) do { const int h_ = (it_) >> 2, row0_ = ((it_) & 3) * 64; \
        _Pragma("unroll") for (int i = 0; i < 2; ++i) { pgz[i] = (u32x4){0u, 0u, 0u, 0u}; if (fq < 2) pgz[i] = *(const u32x4*)(Zp + (size_t)(row0_ + 16 * (2 * wh + i) + fr) * ZROWB + (C_GZ + 8 * fq) * 2); } \
        _Pragma("unroll") for (int i = 0; i < 8; ++i) { const unsigned char* zr = Zp + (size_t)(row0_ + tq * 8 + i) * ZROWB; \
            if (PASS == 2) pq[i] = *(const bf16_t*)(zr + (C_Q + h_ * 64 + d_) * 2); pk[i] = *(const bf16_t*)(zr + (C_K + h_ * 64 + d_) * 2); } \
        _Pragma("unroll") for (int i = 0; i < 8; ++i) pv[i] = *(const unsigned*)(Zp + (size_t)(row0_ + tq * 8 + i) * ZROWB + (C_V + h_ * 128 + 2 * d_) * 2); \
        if (PASS == 2) { _Pragma("unroll") for (int k = 0; k < 4; ++k) pr[k] = *(const u32x2*)(Zp + (size_t)(row0_ + 16 * wq + fr) * ZROWB + (C_R + h_ * 128 + 16 * (wh * 4 + k) + 4 * fq) * 2); } } while (0)
    GLA_LOAD(0);
    float bg = 0.f; f32x4 st[4]; float dprod = 1.f;
#pragma unroll
    for (int k = 0; k < 4; ++k) st[k] = (f32x4){0.f, 0.f, 0.f, 0.f};
    float* Sg = (float*)(ws + WS_GLAS) + ((size_t)panel * 4) * 8192;
    bf16x8 wfr = (bf16x8){0, 0, 0, 0, 0, 0, 0, 0};
#define GLA_WFRAG(h_) do { u32x4 w_ = (u32x4){0u, 0u, 0u, 0u}; if (fq < 2) { const float* wp_ = a.in[13] + (size_t)(l * 16 + 8 * fq) * 256 + (h_) * 64 + 16 * wq + fr; \
        w_.x = pk2(wp_[0], wp_[256]); w_.y = pk2(wp_[512], wp_[768]); w_.z = pk2(wp_[1024], wp_[1280]); w_.w = pk2(wp_[1536], wp_[1792]); } wfr = __builtin_bit_cast(bf16x8, w_); } while (0)
#define GLA_XTILE(g0_, g1_) do { const f32x4 x0_ = mfma16(wfr, __builtin_bit_cast(bf16x8, g0_), (f32x4){0.f, 0.f, 0.f, 0.f}), x1_ = mfma16(wfr, __builtin_bit_cast(bf16x8, g1_), (f32x4){0.f, 0.f, 0.f, 0.f}); \
        *(LAS f32x4*)(lds + GL_X + ((16 * (2 * wh) + fr) * GXS + 16 * wq + 4 * fq) * 4) = x0_; *(LAS f32x4*)(lds + GL_X + ((16 * (2 * wh + 1) + fr) * GXS + 16 * wq + 4 * fq) * 4) = x1_; } while (0)
    f32x4 ngv[4];
#pragma unroll
    for (int k = 0; k < 4; ++k) ngv[k] = (PASS == 2) ? *(const f32x4*)(a.in[15] + l * 128 + 16 * (wh * 4 + k) + 4 * fq) : (f32x4){0.f, 0.f, 0.f, 0.f};
    GLA_WFRAG(0);
    GLA_XTILE(pgz[0], pgz[1]);
    __syncthreads();
#pragma unroll 1
    for (int it = 0; it < 16; ++it) {
        const int h = it >> 2, c = it & 3, row0 = c * 64;
        if (c == 0) {
            bg = a.in[14][l * 256 + h * 64 + d_];
            Sg = (float*)(ws + WS_GLAS) + ((size_t)panel * 4 + h) * 8192;
#pragma unroll
            for (int k = 0; k < 4; ++k) {
                const int et = wh * 4 + k;
#pragma unroll
                for (int r = 0; r < 4; ++r) {
                    const int e = 16 * et + 4 * fq + r, d = 16 * wq + fr;
                    if (PASS == 2) { const float v = Sg[e * 64 + d]; st[k][r] = v; *(LAS bf16_t*)(lds + GL_ST + e * GRS + d * 2) = (bf16_t)f2bf(v); }
                    else st[k][r] = 0.f;
                }
            }
            dprod = 1.f;
        }
        float qv[8], kv[8]; unsigned vpk[8]; u32x2 rvv[4];
#pragma unroll
        for (int i = 0; i < 8; ++i) { qv[i] = (PASS == 2) ? bf1(pq[i]) : 0.f; kv[i] = bf1(pk[i]); vpk[i] = pv[i]; }
#pragma unroll
        for (int k = 0; k < 4; ++k) rvv[k] = pr[k];
        if (it + 1 < 16) GLA_LOAD(it + 1);
        float gl[8];
#pragma unroll
        for (int i = 0; i < 8; ++i) {
            const float x = bg + *(const LAS float*)(lds + GL_X + ((tq * 8 + i) * GXS + d_) * 4);
            const float ls = fminf(x, 0.f) - __logf(1.f + __expf(-fabsf(x)));
            gl[i] = ls * 0.0625f + (i ? gl[i - 1] : 0.f);
        }
        GP[tq * 64 + d_] = gl[7];
        __syncthreads();
        float off = 0.f, tot = 0.f;
#pragma unroll
        for (int k = 0; k < 8; ++k) { const float v = GP[k * 64 + d_]; tot += v; if (k < tq) off += v; }
        float kd[8];
#pragma unroll
        for (int i = 0; i < 8; ++i) {
            const float bc = off + gl[i];
            if (PASS == 2) {
                const float eb = __expf(bc);
                const unsigned qk = pk2(qv[i] * 0.125f * eb, kv[i] * __builtin_amdgcn_rcpf(eb));
                *(LAS bf16_t*)(lds + GL_QE + (tq * 8 + i) * GRS + d_ * 2) = (bf16_t)(qk & 0xffffu);
                *(LAS bf16_t*)(lds + GL_KE + (tq * 8 + i) * GRS + d_ * 2) = (bf16_t)(qk >> 16);
            }
            kd[i] = kv[i] * __expf(tot - bc);
        }
        { u32x4 w; w.x = pk2(kd[0], kd[1]); w.y = pk2(kd[2], kd[3]); w.z = pk2(kd[4], kd[5]); w.w = pk2(kd[6], kd[7]);
          *(LAS u32x4*)(lds + GL_KDT + d_ * GRS + tq * 16) = w; }
        if (tq == 0) DK[d_] = __expf(tot);
        {
            u32x4 w0, w1;
            w0.x = __builtin_amdgcn_perm(vpk[1], vpk[0], 0x05040100u); w0.y = __builtin_amdgcn_perm(vpk[3], vpk[2], 0x05040100u); w0.z = __builtin_amdgcn_perm(vpk[5], vpk[4], 0x05040100u); w0.w = __builtin_amdgcn_perm(vpk[7], vpk[6], 0x05040100u);
            w1.x = __builtin_amdgcn_perm(vpk[1], vpk[0], 0x07060302u); w1.y = __builtin_amdgcn_perm(vpk[3], vpk[2], 0x07060302u); w1.z = __builtin_amdgcn_perm(vpk[5], vpk[4], 0x07060302u); w1.w = __builtin_amdgcn_perm(vpk[7], vpk[6], 0x07060302u);
            *(LAS u32x4*)(lds + GL_VT + (2 * d_) * GRS + tq * 16) = w0; *(LAS u32x4*)(lds + GL_VT + (2 * d_ + 1) * GRS + tq * 16) = w1; }
        __syncthreads();
        f32x4 o[4];
        if (PASS == 2) {
#pragma unroll
            for (int jj = 0; jj < 2; ++jj) {
                const int jt = 2 * wh + jj;
                f32x4 acc = (f32x4){0.f, 0.f, 0.f, 0.f};
#pragma unroll
                for (int ks = 0; ks < 2; ++ks) acc = mfma16(*(const LAS bf16x8*)(lds + GL_KE + (16 * jt + fr) * GRS + (32 * ks + 8 * fq) * 2),
                                                            *(const LAS bf16x8*)(lds + GL_QE + (16 * wq + fr) * GRS + (32 * ks + 8 * fq) * 2), acc);
                const int i = 16 * wq + fr, j0 = 16 * jt + 4 * fq;
                u32x2 w; w.x = pk2(j0 <= i ? acc[0] : 0.f, j0 + 1 <= i ? acc[1] : 0.f); w.y = pk2(j0 + 2 <= i ? acc[2] : 0.f, j0 + 3 <= i ? acc[3] : 0.f);
                *(LAS u32x2*)(lds + GL_SC + i * GRS + j0 * 2) = w;
            }
            __syncthreads();
            float ss = 0.f;
#pragma unroll
            for (int k = 0; k < 4; ++k) {
                const int et = wh * 4 + k;
                f32x4 acc = (f32x4){0.f, 0.f, 0.f, 0.f};
#pragma unroll
                for (int ks = 0; ks < 2; ++ks) {
                    if (ks == 0 || wq >= 2) acc = mfma16(*(const LAS bf16x8*)(lds + GL_VT + (16 * et + fr) * GRS + (32 * ks + 8 * fq) * 2),
                                                         *(const LAS bf16x8*)(lds + GL_SC + (16 * wq + fr) * GRS + (32 * ks + 8 * fq) * 2), acc);
                }
#pragma unroll
                for (int ks = 0; ks < 2; ++ks) acc = mfma16(*(const LAS bf16x8*)(lds + GL_ST + (16 * et + fr) * GRS + (32 * ks + 8 * fq) * 2),
                                                            *(const LAS bf16x8*)(lds + GL_QE + (16 * wq + fr) * GRS + (32 * ks + 8 * fq) * 2), acc);
                o[k] = acc; ss += (acc[0] * acc[0] + acc[1] * acc[1]) + (acc[2] * acc[2] + acc[3] * acc[3]);
            }
            ss += __shfl_xor(ss, 16); ss += __shfl_xor(ss, 32);
            if (fq == 0) SS[(16 * wq + fr) * 2 + wh] = ss;
        }
        {
            const float dk = DK[16 * wq + fr];
            dprod *= dk;
#pragma unroll
            for (int k = 0; k < 4; ++k) {
                const int et = wh * 4 + k;
                f32x4 acc = st[k] * dk;
#pragma unroll
                for (int ks = 0; ks < 2; ++ks) acc = mfma16(*(const LAS bf16x8*)(lds + GL_VT + (16 * et + fr) * GRS + (32 * ks + 8 * fq) * 2),
                                                            *(const LAS bf16x8*)(lds + GL_KDT + (16 * wq + fr) * GRS + (32 * ks + 8 * fq) * 2), acc);
                st[k] = acc;
            }
        }
        if (it + 1 < 16) {
            if (c == 3) GLA_WFRAG(h + 1);
            GLA_XTILE(pgz[0], pgz[1]);
        }
        __syncthreads();
        if (PASS == 2) {
            const int i = 16 * wq + fr;
            const float rs = rsqrtf((SS[i * 2] + SS[i * 2 + 1]) * (1.f / 128.f) + 1e-6f);
#pragma unroll
            for (int k = 0; k < 4; ++k) {
                const int e0 = 16 * (wh * 4 + k) + 4 * fq;
                const f32x4 ng = ngv[k];
                const u32x2 rv = rvv[k];
                const float r0 = bflo(rv.x), r1 = bfhi(rv.x), r2 = bflo(rv.y), r3 = bfhi(rv.y);
                u32x2 w; w.x = pk2(o[k][0] * rs * ng[0] * r0 * sigmoidf_(r0), o[k][1] * rs * ng[1] * r1 * sigmoidf_(r1));
                w.y = pk2(o[k][2] * rs * ng[2] * r2 * sigmoidf_(r2), o[k][3] * rs * ng[3] * r3 * sigmoidf_(r3));
                *(u32x2*)(MIX + (size_t)(row0 + i) * 2048 + (256 + h * 128 + e0) * 2) = w;
                { const unsigned s01 = pk2(st[k][0], st[k][1]), s23 = pk2(st[k][2], st[k][3]);
                  *(LAS bf16_t*)(lds + GL_ST + (e0 + 0) * GRS + (16 * wq + fr) * 2) = (bf16_t)(s01 & 0xffffu); *(LAS bf16_t*)(lds + GL_ST + (e0 + 1) * GRS + (16 * wq + fr) * 2) = (bf16_t)(s01 >> 16);
                  *(LAS bf16_t*)(lds + GL_ST + (e0 + 2) * GRS + (16 * wq + fr) * 2) = (bf16_t)(s23 & 0xffffu); *(LAS bf16_t*)(lds + GL_ST + (e0 + 3) * GRS + (16 * wq + fr) * 2) = (bf16_t)(s23 >> 16); }
            }
        }
        if (c == 3) {
            if (PASS == 1) {
#pragma unroll
                for (int k = 0; k < 4; ++k)
#pragma unroll
                    for (int r = 0; r < 4; ++r) Sg[(16 * (wh * 4 + k) + 4 * fq + r) * 64 + 16 * wq + fr] = st[k][r];
                if (wh == 0 && fq == 0) ((float*)(ws + WS_GLAD))[((size_t)panel * 4 + h) * 64 + 16 * wq + fr] = dprod;
            }
            __syncthreads();
        }
    }
#undef GLA_LOAD
#undef GLA_WFRAG
#undef GLA_XTILE
}

__device__ __forceinline__ void scan_phase(CArgs& a, int l) {
    int tid = threadIdx.x; asm volatile("" : "+v"(tid));
    unsigned char* ws = a.ws;
    const int gt = blockIdx.x * 512 + tid;
    for (int idx = gt; idx < 8 * 32768; idx += 131072) {
        const int b = idx >> 15, r = idx & 32767, hh = r >> 13, d = r & 63;
        float* S = (float*)(ws + WS_GLAS) + (size_t)(b * 32) * 32768 + r;
        const float* D = (const float*)(ws + WS_GLAD) + (size_t)(b * 32) * 256 + hh * 64 + d;
        float loc[32], dec[32];
#pragma unroll
        for (int s = 0; s < 32; ++s) { loc[s] = S[(size_t)s * 32768]; dec[s] = D[(size_t)s * 256]; }
        float run = 0.f;
#pragma unroll
        for (int s = 0; s < 32; ++s) { S[(size_t)s * 32768] = run; run = dec[s] * run + loc[s]; }
    }
    if (gt < 2048) {
        const int b = gt >> 8, ch = gt & 255;
        float* B = (float*)(ws + WS_LRUB) + (size_t)(b * 32) * 256 + ch; const float* A = (const float*)(ws + WS_LRUA) + (size_t)(b * 32) * 256 + ch;
        float loc[32], dec[32];
#pragma unroll
        for (int s = 0; s < 32; ++s) { loc[s] = B[s * 256]; dec[s] = A[s * 256]; }
        float run = 0.f;
#pragma unroll
        for (int s = 0; s < 32; ++s) { B[s * 256] = run; run = dec[s] * run + loc[s]; }
    } else if (gt >= 4096 && gt < 4096 + 8192) {
        const int q = gt - 4096, b = q >> 10, g = (q >> 6) & 15, p = q & 63;
        const float* Ap = (const float*)(ws + WS_S5A) + ((size_t)(l * 16 + g) * 64 + p) * 4;
        const float ar = Ap[2], ai = Ap[3];
        float* H = (float*)(ws + WS_S5H) + ((size_t)(b * 32) * 16 + g) * 128 + 2 * p;
        float rr = 0.f, ri = 0.f;
        f32x2 hv[32];
#pragma unroll
        for (int s = 0; s < 32; ++s) hv[s] = *(const f32x2*)(H + (size_t)s * 2048);
#pragma unroll
        for (int s = 0; s < 32; ++s) { *(f32x2*)(H + (size_t)s * 2048) = (f32x2){rr, ri};
            const float nr = ar * rr - ai * ri + hv[s].x, ni = ar * ri + ai * rr + hv[s].y; rr = nr; ri = ni; }
    }
}

#define XB_TMO      128
#define XB_XCNT(j)  (256  + 64 * (j))
#define XB_XSUB(j)  (1280 + 64 * (j))
#define XB_XGEN(j)  (2304 + 64 * (j))
#define XB_TOP      3328
#define XB_TOPGEN   3392
#define XCD_BAR_WORDS 3456
#define XB_SPIN_CAP (1u << 18)

__device__ __forceinline__ unsigned xb_ld(unsigned* p)              { return __hip_atomic_load(p, __ATOMIC_RELAXED, __HIP_MEMORY_SCOPE_AGENT); }
__device__ __forceinline__ unsigned xb_add(unsigned* p, unsigned v) { return __hip_atomic_fetch_add(p, v, __ATOMIC_RELAXED, __HIP_MEMORY_SCOPE_AGENT); }
__device__ __forceinline__ unsigned xb_xcc_id() { return (unsigned)__builtin_amdgcn_s_getreg((3 << 11) | 20) & 0xFu; }
#define XB_SPIN(cond, bar) do { unsigned _sp = 0; while (cond) { __builtin_amdgcn_s_sleep(1); \
    if ((++_sp & 255u) == 0u) { if (xb_ld(&(bar)[XB_TMO])) break; if (_sp > XB_SPIN_CAP) { atomicAdd(&(bar)[XB_TMO], 1u); break; } } } } while (0)

struct XcdBarrier {
    unsigned* bar; unsigned x;
    volatile LAS unsigned* st;
};

__device__ __forceinline__ XcdBarrier xcd_barrier_post(unsigned* bar, volatile LAS unsigned* st) {
    XcdBarrier b; b.bar = bar; b.x = xb_xcc_id(); b.st = st;
    if (threadIdx.x == 0) (void)xb_add(&bar[XB_XCNT(b.x)], 1u);
    return b;
}
__device__ __forceinline__ void xcd_barrier_complete(unsigned* bar, unsigned x, unsigned& nloc, unsigned& nx) {
    const unsigned G = gridDim.x * gridDim.y * gridDim.z;
    unsigned sum, cnt, mine, sp = 0u;
    for (;;) {
        sum = 0u; cnt = 0u; mine = 0u;
#pragma unroll
        for (unsigned j = 0; j < 16; ++j) { const unsigned c = xb_ld(&bar[XB_XCNT(j)]); sum += c; cnt += (c > 0u) ? 1u : 0u; mine = (j == x) ? c : mine; }
        if (sum == G) break;
        __builtin_amdgcn_s_sleep(1);
        if ((++sp & 255u) == 0u) { if (xb_ld(&bar[XB_TMO])) break; if (sp > XB_SPIN_CAP) { atomicAdd(&bar[XB_TMO], 1u); break; } }
    }
    nloc = mine > 0u ? mine : 1u; nx = cnt > 0u ? cnt : 1u;
}

__device__ __forceinline__ void xcd_barrier(const XcdBarrier& b) {
    asm volatile("s_waitcnt vmcnt(0)" ::: "memory");
    __syncthreads();
    if (threadIdx.x == 0) {
        unsigned* bar = b.bar;
        __builtin_amdgcn_s_waitcnt(0);
        unsigned nloc = b.st[0], nx = b.st[1];
        if (nloc == 0u) { xcd_barrier_complete(bar, b.x, nloc, nx); b.st[0] = nloc; b.st[1] = nx; }
        const unsigned old = xb_add(&bar[XB_XSUB(b.x)], 1u);
        const unsigned gen = old / nloc;
        if (old + 1u == (gen + 1u) * nloc) {
            __builtin_amdgcn_fence(__ATOMIC_RELEASE, "agent");
            asm volatile("s_waitcnt vmcnt(0)" ::: "memory");
            const unsigned og = xb_add(&bar[XB_TOP], 1u);
            const unsigned tg = og / nx;
            if (og + 1u == (tg + 1u) * nx) xb_add(&bar[XB_TOPGEN], 1u);
            else XB_SPIN(xb_ld(&bar[XB_TOPGEN]) == tg, bar);
            __builtin_amdgcn_fence(__ATOMIC_ACQUIRE, "agent");
            xb_add(&bar[XB_XGEN(b.x)], 1u);
            asm volatile("s_waitcnt vmcnt(0)" ::: "memory");
        } else {
            XB_SPIN(xb_ld(&bar[XB_XGEN(b.x)]) == gen, bar);
            __builtin_amdgcn_fence(__ATOMIC_ACQUIRE, "agent");
            asm volatile("s_waitcnt vmcnt(0)" ::: "memory");
        }
    }
    __syncthreads();
}


__global__ void __launch_bounds__(512, 2) fwd_megakernel(Args a) {
    extern __shared__ __attribute__((aligned(16))) unsigned char lds_raw[];
    LAS unsigned char* lds = (LAS unsigned char*)lds_raw;
    cg::grid_group grid = cg::this_grid();
    const int panel = blockIdx.x;
    if (threadIdx.x < 2) ((LAS unsigned*)(lds + LDS_XB))[threadIdx.x] = 0u;
    __syncthreads();
    const XcdBarrier xbar = xcd_barrier_post((unsigned*)kargs()->ws, (volatile LAS unsigned*)(lds + LDS_XB));
#define PHASE_PTRS() CArgs* ka = kargs(); unsigned char* ws = ka->ws; unsigned char* PB = ws + WS_PANEL + (size_t)panel * PANEL_BYTES; \
        bf16_t* HBp = (bf16_t*)(ws + WS_HB) + (size_t)panel * 256 * DM; float* Hp = ka->out + (size_t)panel * 256 * DM; (void)PB; (void)HBp; (void)Hp

#ifndef NO_PRO
    prologue(*kargs(), lds, panel, (int)gridDim.x);
#endif
    grid.sync();

#ifdef ONE_LAYER
    for (int l = 0; l < 1; ++l) {
#else
    for (int l = 0; l < NLAYER; ++l) {
#endif
        gz_phase(*kargs(), l, panel);
        {
            PHASE_PTRS();
            pg8::Gemm g{HBp, (const bf16_t*)(ws + WS_WIN) + (size_t)l * DINP * DM, DM}; pg8::PanelOrder S{NZ_MAIN / 256};
            pg8::EpiBf16<0> E{(bf16_t*)(PB + P_Z), DINP};
#ifndef NO_G1
            pg8::gemm_phase(lds, g, S, E);
#if REP_GEMM
            block_fence(); pg8::gemm_phase(lds, g, S, E);
#endif
#endif
        }
        xcd_barrier(xbar);
#ifndef NO_LRU
        lru_pass<1>(*kargs(), l, panel);
#endif
#ifndef NO_S5
        s5_pass<1>(*kargs(), lds, l, panel);
#endif
        __syncthreads();
#ifndef NO_GLA
        gla_pass<1>(*kargs(), lds, l, panel);
#endif
#if REP_MIX
        __syncthreads(); lru_pass<1>(*kargs(), l, panel); s5_pass<1>(*kargs(), lds, l, panel); __syncthreads(); gla_pass<1>(*kargs(), lds, l, panel);
#endif
#if REP_GLA
        __syncthreads(); gla_pass<1>(*kargs(), lds, l, panel);
#endif
#if REP_S5
        __syncthreads(); s5_pass<1>(*kargs(), lds, l, panel); __syncthreads();
#endif
        xcd_barrier(xbar);
#ifndef NO_SCAN
        scan_phase(*kargs(), l);
#endif
        xcd_barrier(xbar);
#ifndef NO_LRU
        lru_apply(*kargs(), l, panel);
#endif
#ifndef NO_S5
        s5_pass<2>(*kargs(), lds, l, panel);
#endif
        __syncthreads();
#ifndef NO_GLA
        gla_pass<2>(*kargs(), lds, l, panel);
#endif
#if REP_MIX
        __syncthreads(); lru_apply(*kargs(), l, panel); s5_pass<2>(*kargs(), lds, l, panel); __syncthreads(); gla_pass<2>(*kargs(), lds, l, panel);
#endif
#if REP_GLA
        __syncthreads(); gla_pass<2>(*kargs(), lds, l, panel);
#endif
#if REP_S5
        __syncthreads(); s5_pass<2>(*kargs(), lds, l, panel); __syncthreads();
#endif
        block_fence();
        {
            PHASE_PTRS();
            pg8::Gemm g{(const bf16_t*)(PB + P_YS5), (const bf16_t*)(ws + WS_WGLU) + (size_t)l * 256 * 256, 256}; pg8::PanelOrder S{1};
            pg8::EpiGlu E{(const bf16_t*)(PB + P_YS5), 256, (bf16_t*)(PB + P_MIX), DM};
#ifndef NO_G2
            pg8::gemm_phase(lds, g, S, E);
#endif
        }
        block_fence();
        {
            PHASE_PTRS();
            pg8::Gemm g{(const bf16_t*)(PB + P_MIX), (const bf16_t*)(ws + WS_WOUT) + (size_t)l * DM * DM, DM}; pg8::PanelOrder S{DM / 256};
            pg8::EpiRes E{HBp, DM, ALPHA};
#ifndef NO_G3
            pg8::gemm_phase(lds, g, S, E);
#endif
        }
        block_fence();
        { PHASE_PTRS(); ln_panel_b(HBp, nullptr, ka->in[24] + l * DM, ka->in[25] + l * DM); }
        block_fence();
        {
            PHASE_PTRS();
            pg8::Gemm g{HBp, (const bf16_t*)(ws + WS_W1) + (size_t)l * DFF * DM, DM}; pg8::PanelOrder S{DFF / 256};
            pg8::EpiBf16<1> E{(bf16_t*)(PB + P_HID), DFF};
#ifndef NO_G4
            pg8::gemm_phase(lds, g, S, E);
#if REP_GEMM
            block_fence(); pg8::gemm_phase(lds, g, S, E);
#endif
#endif
        }
        block_fence();
        {
            PHASE_PTRS();
            pg8::Gemm g{(const bf16_t*)(PB + P_HID), (const bf16_t*)(ws + WS_W2) + (size_t)l * DM * DFF, DFF}; pg8::PanelOrder S{DM / 256};
            pg8::EpiRes E{HBp, DM, ALPHA};
#ifndef NO_G5
            pg8::gemm_phase(lds, g, S, E);
#endif
        }
        block_fence();
        { PHASE_PTRS(); ln_panel_b(HBp, (l + 1 == NLAYER) ? Hp : nullptr, ka->in[28] + l * DM, ka->in[29] + l * DM); }
        block_fence();
    }
}

extern "C" void kernel_launch(void* const* d_in, const int* in_sizes, int n_in, void* d_out, int out_size, void* d_ws, size_t ws_size, hipStream_t stream) {
    static int ready = 0;
    if (ready == 0) {
        if (n_in != 30 || in_sizes[0] != M_TOK * DM || out_size != M_TOK * DM || ws_size < WS_END) {
            fprintf(stderr, "kernel_launch: unexpected shapes (n_in %d, in0 %d, out %d, ws %zu)\n", n_in, n_in > 0 ? in_sizes[0] : -1, out_size, ws_size); ready = -1; return; }
        if (hipFuncSetAttribute((const void*)fwd_megakernel, hipFuncAttributeMaxDynamicSharedMemorySize, LDS_BYTES) != hipSuccess) { fprintf(stderr, "kernel_launch: hipFuncSetAttribute failed\n"); ready = -1; return; }
        int dev = 0, cus = 0, per_cu = 0;
        hipGetDevice(&dev); hipDeviceGetAttribute(&cus, hipDeviceAttributeMultiprocessorCount, dev);
        hipOccupancyMaxActiveBlocksPerMultiprocessor(&per_cu, (const void*)fwd_megakernel, 512, LDS_BYTES);
        if (cus * per_cu < NPANEL) fprintf(stderr, "kernel_launch: note: %d CUs x %d blocks/CU < %d workgroups\n", cus, per_cu, NPANEL);
        (void)hipGetLastError();
        ready = 1;
    }
    if (ready < 0) return;
    if (hipMemsetAsync(d_ws, 0, 16384, stream) != hipSuccess) { fprintf(stderr, "kernel_launch: hipMemsetAsync failed\n"); return; }
    Args a{};
    for (int i = 0; i < 30; ++i) a.in[i] = (const float*)d_in[i];
    a.out = (float*)d_out; a.ws = (unsigned char*)d_ws;
    void* args[] = {&a};
    hipError_t e = hipLaunchCooperativeKernel((const void*)fwd_megakernel, dim3(NPANEL), dim3(512), args, LDS_BYTES, stream);
    if (e != hipSuccess) fprintf(stderr, "kernel_launch: cooperative launch failed: %s\n", hipGetErrorString(e));
}
```

```cpp
#include <hip/hip_runtime.h>
#include <hip/hip_cooperative_groups.h>
#include <cstdio>
#include <cstdint>
namespace cg = cooperative_groups;
#ifndef REP_GEMM
#define REP_GEMM 0
#endif
#ifndef REP_GLA
#define REP_GLA 0
#endif
#ifndef REP_S5
#define REP_S5 0
#endif
#ifndef REP_MIX
#define REP_MIX 0
#endif

#define LAS __attribute__((address_space(3)))
typedef unsigned short bf16_t;
typedef short bf16x8 __attribute__((ext_vector_type(8)));
typedef float f32x4 __attribute__((ext_vector_type(4)));
typedef float f32x2 __attribute__((ext_vector_type(2)));
typedef unsigned u32x4 __attribute__((ext_vector_type(4)));
typedef unsigned u32x2 __attribute__((ext_vector_type(2)));

__device__ __forceinline__ float fexp(float x) { return __builtin_amdgcn_exp2f(x * 1.4426950408889634f); }
__device__ __forceinline__ float flog(float x) { return __builtin_amdgcn_logf(x) * 0.6931471805599453f; }
namespace pg8 {
constexpr int BM = 256, BK = 64, HALF = 128, HTB = HALF * BK * 2, STAGE_BYTES = 8 * HTB;
__host__ __device__ __forceinline__ int lds_byte(int r, int c) { const int st = (r >> 4) * 2 + (c >> 5), rr = r & 15, cc = c & 31, ob = rr * 64 + cc * 2; return st * 1024 + (ob ^ (((ob >> 9) & 1) << 5)); }
__host__ __device__ __forceinline__ void stage_rc(int b, int& R, int& C) { const int st = b / 1024, sb = b % 1024, swz = sb ^ (((sb >> 9) & 1) << 5); R = (st >> 1) * 16 + swz / 64; C = (st & 1) * 32 + (swz % 64) / 2; }
__host__ __device__ __forceinline__ int perm32(int rho) { const int n = rho >> 4, i = rho & 15; return 8 * (i >> 2) + 4 * n + (i & 3); }
struct Unit { int pm, pn; };
struct Gemm { const bf16_t* A; const bf16_t* Bt; int K; };
struct PanelOrder {
    int nN;
    __device__ __forceinline__ bool next(int i, Unit& u) const { u.pm = 0; u.pn = i; return i < nN; }
    __device__ __forceinline__ void a_ready(const Unit&) const {}
    __device__ __forceinline__ void done(const Unit&) const {}
};
__device__ __forceinline__ float bflo_(unsigned w) { return __uint_as_float(w << 16); }
__device__ __forceinline__ float bfhi_(unsigned w) { return __uint_as_float(w & 0xffff0000u); }
__device__ __forceinline__ unsigned cvt_pk_bf16(float lo, float hi) { unsigned r; asm volatile("v_cvt_pk_bf16_f32 %0, %1, %2" : "=v"(r) : "v"(lo), "v"(hi)); return r; }

template <class Epi, class Sched>
__device__ __forceinline__ void gemm_phase(LAS unsigned char* lds, const Gemm g, const Sched& S, const Epi& E) {
    int tid = threadIdx.x; asm volatile("" : "+v"(tid));
    const int wid = __builtin_amdgcn_readfirstlane(tid >> 6), lane = tid & 63, wr = wid >> 2, wc = wid & 3, fr = lane & 15, fq = lane >> 4;
    int K = g.K; asm volatile("" : "+s"(K));
    const int nt = K / BK;
    unsigned voffA[2], voffB[2];
#pragma unroll
    for (int i = 0; i < 2; ++i) { int R, C; stage_rc(tid * 16 + i * 8192, R, C); const int Rb = Epi::PERM ? ((R & ~31) + perm32(R & 31)) : R;
        voffA[i] = (unsigned)(R * K + C) * 2u; voffB[i] = (unsigned)(Rb * K + C) * 2u; }
    const size_t kstep = (size_t)(BK * 2);
    const size_t hstep = (size_t)HALF * K * 2;
    const size_t tstep = 2 * hstep;
    const unsigned ldsw = (unsigned)wid * 1024u;
    const int aoff = lds_byte(wr * 64 + fr, fq * 8), boff = lds_byte(wc * 32 + fr, fq * 8);
#define PG8_SA(b, h) (((b) * 2 + (h)) * HTB)
#define PG8_SB(b, h) ((4 + (b) * 2 + (h)) * HTB)
#define PG8_STAGE(bufoff, gbase, voff) do { _Pragma("unroll") for (int _i = 0; _i < 2; ++_i) \
        __builtin_amdgcn_global_load_lds((const unsigned*)((const char*)(gbase) + (voff)[_i]), (LAS unsigned*)(lds + (bufoff) + ldsw + _i * 8192), 16, 0, 0); } while (0)
#define PG8_LDA(dst, b, h) do { _Pragma("unroll") for (int m = 0; m < 4; ++m) _Pragma("unroll") for (int k = 0; k < 2; ++k) dst[m][k] = *(const LAS bf16x8*)(lds + PG8_SA(b, h) + aoff + m * 2048 + k * 1024); } while (0)
#define PG8_LDB(dst, b, h) do { _Pragma("unroll") for (int n = 0; n < 2; ++n) _Pragma("unroll") for (int k = 0; k < 2; ++k) dst[n][k] = *(const LAS bf16x8*)(lds + PG8_SB(b, h) + boff + n * 2048 + k * 1024); } while (0)
#define PG8_MMA(ai, bj, At, Bt) do { __builtin_amdgcn_s_setprio(1); _Pragma("unroll") for (int m = 0; m < 4; ++m) _Pragma("unroll") for (int n = 0; n < 2; ++n) _Pragma("unroll") for (int k = 0; k < 2; ++k) \
        acc[ai][bj][m][n] = __builtin_amdgcn_mfma_f32_16x16x32_bf16(Bt[n][k], At[m][k], acc[ai][bj][m][n], 0, 0, 0); __builtin_amdgcn_s_setprio(0); } while (0)
#define PG8_WAIT_V(n) asm volatile("s_waitcnt vmcnt(" #n ")" ::: "memory")
#define PG8_WAIT_L(n) asm volatile("s_waitcnt lgkmcnt(" #n ")" ::: "memory")
#define PG8_BAR __builtin_amdgcn_s_barrier()
#define PG8_SCHED __builtin_amdgcn_sched_barrier(0)
    Unit cur, nxt; int ui = 0;
    if (!S.next(0, cur)) return;
    f32x4 acc[2][2][4][2];
#pragma unroll
    for (int a = 0; a < 2; ++a)
#pragma unroll
        for (int b = 0; b < 2; ++b)
#pragma unroll
            for (int m = 0; m < 4; ++m)
#pragma unroll
                for (int n = 0; n < 2; ++n) acc[a][b][m][n] = (f32x4){0.f, 0.f, 0.f, 0.f};
    bf16x8 At[4][2], B0[2][2], B1[2][2];
    const char* cA = (const char*)g.A + (size_t)cur.pm * tstep; const char* cB = (const char*)g.Bt + (size_t)cur.pn * tstep;
    S.a_ready(cur);
    PG8_STAGE(PG8_SB(0, 0), cB, voffB); PG8_STAGE(PG8_SB(0, 1), cB + hstep, voffB); PG8_STAGE(PG8_SA(0, 0), cA, voffA); PG8_STAGE(PG8_SA(0, 1), cA + hstep, voffA);
    if (wr == 1) PG8_BAR;
    PG8_WAIT_V(2); PG8_BAR;
    PG8_STAGE(PG8_SB(1, 0), cB + kstep, voffB); PG8_STAGE(PG8_SA(1, 0), cA + kstep, voffA); PG8_STAGE(PG8_SB(1, 1), cB + hstep + kstep, voffB);
    PG8_WAIT_V(6); PG8_BAR;
    for (;;) {
        const bool has_next = S.next(ui + 1, nxt);
        const char* nA = has_next ? (const char*)g.A + (size_t)nxt.pm * tstep : cA; const char* nB = has_next ? (const char*)g.Bt + (size_t)nxt.pn * tstep : cB;
        for (int t = 0; t < nt; t += 2) {
            const bool last = (t == nt - 2);
            const char* a1 = cA + (size_t)(t + 1) * kstep;
            const char* a2 = last ? nA : cA + (size_t)(t + 2) * kstep; const char* b2 = last ? nB : cB + (size_t)(t + 2) * kstep;
            const char* a3 = a2 + kstep; const char* b3 = b2 + kstep;
            if (last && has_next) S.a_ready(nxt);
            PG8_LDB(B0, 0, 0); PG8_LDB(B1, 0, 1); PG8_SCHED; PG8_LDA(At, 0, 0); PG8_STAGE(PG8_SA(1, 1), a1 + hstep, voffA);
            PG8_WAIT_V(8); PG8_WAIT_L(0); PG8_BAR; PG8_MMA(0, 0, At, B0); PG8_MMA(0, 1, At, B1); PG8_BAR; PG8_SCHED;
            PG8_LDA(At, 0, 1); PG8_STAGE(PG8_SB(0, 0), b2, voffB); PG8_STAGE(PG8_SB(0, 1), b2 + hstep, voffB); PG8_STAGE(PG8_SA(0, 0), a2, voffA);
            PG8_WAIT_V(8); PG8_WAIT_L(0); PG8_BAR; PG8_MMA(1, 0, At, B0); PG8_MMA(1, 1, At, B1); PG8_BAR; PG8_SCHED;
            PG8_LDB(B0, 1, 0); PG8_LDB(B1, 1, 1); PG8_SCHED; PG8_LDA(At, 1, 0); PG8_STAGE(PG8_SA(0, 1), a2 + hstep, voffA);
            PG8_WAIT_V(8); PG8_WAIT_L(0); PG8_BAR; PG8_MMA(0, 0, At, B0); PG8_MMA(0, 1, At, B1); PG8_BAR; PG8_SCHED;
            PG8_LDA(At, 1, 1); PG8_STAGE(PG8_SB(1, 0), b3, voffB); PG8_STAGE(PG8_SB(1, 1), b3 + hstep, voffB); PG8_STAGE(PG8_SA(1, 0), a3, voffA);
            PG8_WAIT_V(8); PG8_WAIT_L(0); PG8_BAR; PG8_MMA(1, 0, At, B0); PG8_MMA(1, 1, At, B1); PG8_BAR; PG8_SCHED;
        }
        if (wr == 0) PG8_BAR;
        E(acc, cur, wr, wc, fr, fq); S.done(cur);
        if (!has_next) break;
#pragma unroll
        for (int a = 0; a < 2; ++a)
#pragma unroll
            for (int b = 0; b < 2; ++b)
#pragma unroll
                for (int m = 0; m < 4; ++m)
#pragma unroll
                    for (int n = 0; n < 2; ++n) acc[a][b][m][n] = (f32x4){0.f, 0.f, 0.f, 0.f};
        cur = nxt; cA = nA; cB = nB; ++ui;
        if (wr == 1) PG8_BAR;
    }
    PG8_WAIT_V(0);
    PG8_BAR;
#undef PG8_SA
#undef PG8_SB
#undef PG8_STAGE
#undef PG8_LDA
#undef PG8_LDB
#undef PG8_MMA
#undef PG8_WAIT_V
#undef PG8_WAIT_L
#undef PG8_BAR
#undef PG8_SCHED
}

#define PG8_OPQ(p) asm volatile("" : "+v"(p))
template <int ACT  > struct EpiBf16 {
    static constexpr bool PERM = true;
    bf16_t* O; int ldc;
    __device__ __forceinline__ void operator()(const f32x4 (&acc)[2][2][4][2], const Unit& u, int wr, int wc, int fr, int fq) const {
        char* p = (char*)(O + (size_t)(wr * 64 + fr) * ldc + u.pn * BM + wc * 32 + 8 * fq);
        const size_t step = (size_t)16 * ldc * 2;
#pragma unroll
        for (int ai = 0; ai < 2; ++ai) {
#pragma unroll
            for (int m = 0; m < 4; ++m) {
                PG8_OPQ(p);
#pragma unroll
                for (int bj = 0; bj < 2; ++bj) { f32x4 v0 = acc[ai][bj][m][0], v1 = acc[ai][bj][m][1];
                    if (ACT == 1) {
#pragma unroll
                        for (int j = 0; j < 4; ++j) { const float a0 = fmaxf(v0[j], 0.f), a1 = fmaxf(v1[j], 0.f); v0[j] = a0 * a0; v1[j] = a1 * a1; } }
                    u32x4 w; w.x = cvt_pk_bf16(v0[0], v0[1]); w.y = cvt_pk_bf16(v0[2], v0[3]); w.z = cvt_pk_bf16(v1[0], v1[1]); w.w = cvt_pk_bf16(v1[2], v1[3]);
                    *(u32x4*)(p + bj * HALF * 2) = w; }
                p += step;
            }
            p += 4 * step;
        }
    }
};
struct EpiGlu {
    static constexpr bool PERM = true;
    const bf16_t* Y; int ldy; bf16_t* O; int ldc;
    __device__ __forceinline__ void operator()(const f32x4 (&acc)[2][2][4][2], const Unit& u, int wr, int wc, int fr, int fq) const {
        const int col0 = u.pn * BM + wc * 32 + 8 * fq;
        const char* py = (const char*)(Y + (size_t)(wr * 64 + fr) * ldy + col0);
        char* po = (char*)(O + (size_t)(wr * 64 + fr) * ldc + col0);
        const size_t sy = (size_t)16 * ldy * 2, so = (size_t)16 * ldc * 2;
#pragma unroll
        for (int ai = 0; ai < 2; ++ai) {
            PG8_OPQ(py); PG8_OPQ(po);
            u32x4 yv[4][2];
#pragma unroll
            for (int m = 0; m < 4; ++m)
#pragma unroll
                for (int bj = 0; bj < 2; ++bj) yv[m][bj] = *(const u32x4*)(py + m * sy + bj * HALF * 2);
            asm volatile("" ::: "memory");
#pragma unroll
            for (int m = 0; m < 4; ++m)
#pragma unroll
                for (int bj = 0; bj < 2; ++bj) { const f32x4 v0 = acc[ai][bj][m][0], v1 = acc[ai][bj][m][1]; const u32x4 y = yv[m][bj];
                    u32x4 w;
                    w.x = cvt_pk_bf16(bflo_(y.x) * __builtin_amdgcn_rcpf(1.f + fexp(-v0[0])), bfhi_(y.x) * __builtin_amdgcn_rcpf(1.f + fexp(-v0[1])));
                    w.y = cvt_pk_bf16(bflo_(y.y) * __builtin_amdgcn_rcpf(1.f + fexp(-v0[2])), bfhi_(y.y) * __builtin_amdgcn_rcpf(1.f + fexp(-v0[3])));
                    w.z = cvt_pk_bf16(bflo_(y.z) * __builtin_amdgcn_rcpf(1.f + fexp(-v1[0])), bfhi_(y.z) * __builtin_amdgcn_rcpf(1.f + fexp(-v1[1])));
                    w.w = cvt_pk_bf16(bflo_(y.w) * __builtin_amdgcn_rcpf(1.f + fexp(-v1[2])), bfhi_(y.w) * __builtin_amdgcn_rcpf(1.f + fexp(-v1[3])));
                    *(u32x4*)(po + m * so + bj * HALF * 2) = w; }
            py += 8 * sy; po += 8 * so;
        }
    }
};
struct EpiRes {
    static constexpr bool PERM = true;
    bf16_t* HB; int ldc; float alpha;
    __device__ __forceinline__ void operator()(const f32x4 (&acc)[2][2][4][2], const Unit& u, int wr, int wc, int fr, int fq) const {
        char* p = (char*)(HB + (size_t)(wr * 64 + fr) * ldc + u.pn * BM + wc * 32 + 8 * fq);
        const size_t step = (size_t)16 * ldc * 2;
#pragma unroll
        for (int ai = 0; ai < 2; ++ai) {
            PG8_OPQ(p);
            u32x4 h[4][2];
#pragma unroll
            for (int m = 0; m < 4; ++m)
#pragma unroll
                for (int bj = 0; bj < 2; ++bj) h[m][bj] = *(const u32x4*)(p + m * step + bj * HALF * 2);
#pragma unroll
            for (int m = 0; m < 4; ++m)
#pragma unroll
                for (int bj = 0; bj < 2; ++bj) { const f32x4 v0 = acc[ai][bj][m][0], v1 = acc[ai][bj][m][1]; const u32x4 hh = h[m][bj];
                    u32x4 w;
                    w.x = cvt_pk_bf16(bflo_(hh.x) * alpha + v0[0], bfhi_(hh.x) * alpha + v0[1]); w.y = cvt_pk_bf16(bflo_(hh.y) * alpha + v0[2], bfhi_(hh.y) * alpha + v0[3]);
                    w.z = cvt_pk_bf16(bflo_(hh.z) * alpha + v1[0], bfhi_(hh.z) * alpha + v1[1]); w.w = cvt_pk_bf16(bflo_(hh.w) * alpha + v1[2], bfhi_(hh.w) * alpha + v1[3]);
                    *(u32x4*)(p + m * step + bj * HALF * 2) = w; }
            p += 8 * step;
        }
    }
};
}

constexpr int M_TOK = 65536, DM = 1024, DIN = 2320, DINP = 2560, DFF = 4096, NPANEL = 256, NLAYER = 2;
constexpr int C_S5U = 0, C_Q = 256, C_K = 512, C_V = 768, C_R = 1280, C_LX = 1792, C_LG = 2048, C_GZ = 2304, NZ_MAIN = 2304;
constexpr int ZROWB = DINP * 2;
constexpr float ALPHA = 1.4142135623730951f;
constexpr float LN_EPS = 1e-5f;
constexpr size_t MiB = 1u << 20;
constexpr size_t WS_WIN = 2 * MiB, WS_WOUT = 12 * MiB, WS_W1 = 16 * MiB, WS_W2 = 32 * MiB, WS_WGLU = 48 * MiB;
constexpr size_t WS_LRUW = 48 * MiB + 512 * 1024, WS_S5A = 49 * MiB, WS_S5M = 50 * MiB, WS_S5W = 56 * MiB;
constexpr size_t WS_LRUA = 58 * MiB, WS_LRUB = 58 * MiB + 256 * 1024, WS_S5H = 59 * MiB, WS_GLAD = 61 * MiB, WS_GLAS = 64 * MiB;
constexpr size_t WS_HB = 96 * MiB, WS_PANEL = 224 * MiB, PANEL_BYTES = 2 * MiB;
constexpr size_t WS_LRUAB = 736 * MiB, WS_LRUC = 800 * MiB, WS_END = 808 * MiB;
constexpr size_t P_Z = 0, P_MIX = 1310720, P_YS5 = 1310720 + 524288, P_HID = 0;
constexpr int LDS_BYTES = 147456;
constexpr int LDS_TA = 131072, LDS_TB = 131072 + 2048, LDS_XB = 131072 + 8192;

struct Args { const float* in[30]; float* out; unsigned char* ws; };
typedef const Args __attribute__((address_space(4))) CArgs;
__device__ __forceinline__ CArgs* kargs() { CArgs* p = (CArgs*)__builtin_amdgcn_kernarg_segment_ptr(); asm volatile("" : "+s"(p)); return p; }

__device__ __forceinline__ unsigned pk2(float lo, float hi) { unsigned r; asm("v_cvt_pk_bf16_f32 %0, %1, %2" : "=v"(r) : "v"(lo), "v"(hi)); return r; }
__device__ __forceinline__ unsigned f2bf(float f) { return pk2(f, f) & 0xffffu; }
__device__ __forceinline__ float bflo(unsigned w) { return __uint_as_float(w << 16); }
__device__ __forceinline__ float bfhi(unsigned w) { return __uint_as_float(w & 0xffff0000u); }
__device__ __forceinline__ float bf1(bf16_t v) { return __uint_as_float(((unsigned)v) << 16); }
__device__ __forceinline__ float sigmoidf_(float x) { return __builtin_amdgcn_rcpf(1.f + fexp(-x)); }
__device__ __forceinline__ float gelu_tanh(float x) { const float u = 0.7978845608028654f * (x + 0.044715f * x * x * x); return x * __builtin_amdgcn_rcpf(1.f + fexp(-2.f * u)); }
__device__ __forceinline__ void lds_fence() { asm volatile("s_waitcnt lgkmcnt(0)" ::: "memory"); }
__device__ __forceinline__ void block_fence() { __builtin_amdgcn_fence(__ATOMIC_RELEASE, "workgroup"); __syncthreads(); __builtin_amdgcn_fence(__ATOMIC_ACQUIRE, "workgroup"); }
__device__ __forceinline__ float wave_sum(float v) {
#pragma unroll
    for (int o = 1; o < 64; o <<= 1) v += __shfl_xor(v, o);
    return v;
}
__device__ __forceinline__ f32x4 mfma16(bf16x8 a, bf16x8 b, f32x4 c) { return __builtin_amdgcn_mfma_f32_16x16x32_bf16(a, b, c, 0, 0, 0); }

template <bool WIN_PERM = false  >
__device__ __forceinline__ void transpose_item(const float* W, int K, int N, int Npad, bf16_t* WT, LAS float* scr, int item, int lane) {
    const int nblk = Npad / 32, kb = item / nblk, nb = item % nblk, k0 = 64 * kb, n0 = 32 * nb;
    const int nn = n0 + (lane & 31);
    const int sc = !WIN_PERM ? nn : (nn < 1792 ? nn : (nn < 2304 ? nn + 16 : nn - 512));
    float wv[32];
#pragma unroll
    for (int i = 0; i < 32; ++i) { const int kk = 2 * i + (lane >> 5); wv[i] = (nn < N) ? W[(size_t)(k0 + kk) * N + sc] : 0.f; }
#pragma unroll
    for (int i = 0; i < 32; ++i) { const int kk = 2 * i + (lane >> 5); scr[kk * 33 + (lane & 31)] = wv[i]; }
    lds_fence();
    const int c = lane & 7;
#pragma unroll
    for (int j = 0; j < 4; ++j) { const int n = (lane >> 3) + 8 * j; const LAS float* s = scr + (8 * c) * 33 + n;
        u32x4 o; o.x = pk2(s[0 * 33], s[1 * 33]); o.y = pk2(s[2 * 33], s[3 * 33]); o.z = pk2(s[4 * 33], s[5 * 33]); o.w = pk2(s[6 * 33], s[7 * 33]);
        *(u32x4*)(WT + (size_t)(n0 + n) * K + k0 + 8 * c) = o; }
    lds_fence();
}
__device__ __forceinline__ void s5_pow(float lrdt, float rev1, float n, float& pr, float& pi) {
    const float mag = fexp(n * lrdt);
    const float r = n * rev1, rr = __builtin_fmaf(n, rev1, -r);
    const float fr_ = (r - rintf(r)) + rr;
    pr = mag * __builtin_amdgcn_cosf(fr_); pi = mag * __builtin_amdgcn_sinf(fr_);
}
struct S5Lane { float lrdt, rev1, fre, fim; };
__device__ __forceinline__ S5Lane s5_lane(CArgs& a, int l, int g, int p) {
    S5Lane s;
    const float dt = expf(a.in[6][l * 16 + g]);
    const float lr = fminf(a.in[4][(l * 16 + g) * 64 + p], -1e-4f), li = a.in[5][(l * 16 + g) * 64 + p];
    s.lrdt = lr * dt; const float ang = li * dt; s.rev1 = ang * 0.15915494309189535f;
    float ar, ai; s5_pow(s.lrdt, s.rev1, 1.f, ar, ai);
    const float den = lr * lr + li * li;
    s.fre = ((ar - 1.f) * lr + ai * li) / den; s.fim = (ai * lr - (ar - 1.f) * li) / den;
    return s;
}
__device__ __forceinline__ void s5_prep_k(CArgs& a, unsigned char* ws, LAS float* scr, int l, int g, int d, int lane) {
    const int p = lane; const S5Lane s = s5_lane(a, l, g, p);
    float pr, pi; s5_pow(s.lrdt, s.rev1, (float)d, pr, pi);
    const float* bre = a.in[7] + ((size_t)(l * 16 + g) * 64 + p) * 16; const float* bim = a.in[8] + ((size_t)(l * 16 + g) * 64 + p) * 16;
    const float* cre = a.in[9] + (size_t)(l * 16 + g) * 16 * 64 + p; const float* cim = a.in[10] + (size_t)(l * 16 + g) * 16 * 64 + p;
    for (int c = 0; c < 16; ++c) {
        const float cr = cre[c * 64], ci = cim[c * 64];
        scr[(0 * 16 + c) * 65 + p] = cr * pr - ci * pi; scr[(1 * 16 + c) * 65 + p] = cr * pi + ci * pr;
        const float br = bre[c], bi = bim[c];
        scr[(2 * 16 + c) * 65 + p] = s.fre * br - s.fim * bi; scr[(3 * 16 + c) * 65 + p] = s.fre * bi + s.fim * br;
    }
    lds_fence();
    bf16_t* Mg = (bf16_t*)(ws + WS_S5M) + (size_t)(l * 16 + g) * 64 * 192;
    for (int q = 0; q < 4; ++q) {
        const int idx = lane + 64 * q, co = idx >> 4, ci = idx & 15;
        float v = 0.f;
        for (int pp = 0; pp < 64; ++pp) v += scr[(0 * 16 + co) * 65 + pp] * scr[(2 * 16 + ci) * 65 + pp] - scr[(1 * 16 + co) * 65 + pp] * scr[(3 * 16 + ci) * 65 + pp];
        const bf16_t vb = (bf16_t)f2bf(v);
        for (int to = d; to < 4; ++to) {
            Mg[(size_t)(to * 16 + co) * 192 + (to - d) * 16 + ci] = vb;
            if (d > 0) Mg[(size_t)((to - d) * 16 + co) * 192 + to * 16 + ci] = 0;
        }
    }
    lds_fence();
}
__device__ __forceinline__ void s5_prep_vw(CArgs& a, unsigned char* ws, int l, int g, int lane) {
    const int p = lane; const S5Lane s = s5_lane(a, l, g, p);
    float* A = (float*)(ws + WS_S5A) + ((size_t)(l * 16 + g) * 64 + p) * 4;
    { float r4, i4, r256, i256; s5_pow(s.lrdt, s.rev1, 4.f, r4, i4); s5_pow(s.lrdt, s.rev1, 256.f, r256, i256); A[0] = r4; A[1] = i4; A[2] = r256; A[3] = i256; }
    const float* bre = a.in[7] + ((size_t)(l * 16 + g) * 64 + p) * 16; const float* bim = a.in[8] + ((size_t)(l * 16 + g) * 64 + p) * 16;
    const float* cre = a.in[9] + (size_t)(l * 16 + g) * 16 * 64 + p; const float* cim = a.in[10] + (size_t)(l * 16 + g) * 16 * 64 + p;
    bf16_t* Wg = (bf16_t*)(ws + WS_S5W) + (size_t)(l * 16 + g) * 128 * 64;
    bf16_t* Mg = (bf16_t*)(ws + WS_S5M) + (size_t)(l * 16 + g) * 64 * 192;
    float bbr[16], bbi[16], cr[16], ci[16];
#pragma unroll
    for (int c = 0; c < 16; ++c) { const float br = bre[c], bi = bim[c]; bbr[c] = s.fre * br - s.fim * bi; bbi[c] = s.fre * bi + s.fim * br; cr[c] = cre[c * 64]; ci[c] = cim[c * 64]; }
#pragma unroll 1
    for (int t = 0; t < 4; ++t) {
        float pr, pi; s5_pow(s.lrdt, s.rev1, (float)(3 - t), pr, pi);
        float qr, qi; s5_pow(s.lrdt, s.rev1, (float)(t + 1), qr, qi);
#pragma unroll
        for (int c = 0; c < 16; c += 2) {
            *(unsigned*)(Wg + (size_t)(2 * p) * 64 + t * 16 + c) = pk2(pr * bbr[c] - pi * bbi[c], pr * bbr[c + 1] - pi * bbi[c + 1]);
            *(unsigned*)(Wg + (size_t)(2 * p + 1) * 64 + t * 16 + c) = pk2(pr * bbi[c] + pi * bbr[c], pr * bbi[c + 1] + pi * bbr[c + 1]);
        }
#pragma unroll
        for (int c = 0; c < 16; ++c) {
            const float vr = cr[c] * qr - ci[c] * qi, vi = cr[c] * qi + ci[c] * qr;
            *(unsigned*)(Mg + (size_t)(t * 16 + c) * 192 + 64 + 2 * p) = pk2(vr, -vi);
        }
    }
}
__device__ __forceinline__ void ln_panel(const float* src, float* dst, bf16_t* dstb, const float* gam, const float* bet, LAS f32x2* T) {
    int tid_ = threadIdx.x; asm volatile("" : "+v"(tid_));
    const int lane = tid_ & 63, wave = __builtin_amdgcn_readfirstlane(tid_ >> 6);
    constexpr int NB = 2;
    f32x4 cur[NB][4], nxt[NB][4];
    const int r0 = wave * 32;
#pragma unroll
    for (int b = 0; b < NB; ++b)
#pragma unroll
        for (int j = 0; j < 4; ++j) cur[b][j] = ((const f32x4*)(src + (size_t)(r0 + b) * DM))[lane + 64 * j];
    f32x4 gv[4], bv[4];
#pragma unroll
    for (int j = 0; j < 4; ++j) { gv[j] = ((const f32x4*)gam)[lane + 64 * j]; bv[j] = ((const f32x4*)bet)[lane + 64 * j]; }
    for (int it = 0; it < 32 / NB; ++it) {
        const int r = r0 + it * NB;
        if (it + 1 < 32 / NB) {
#pragma unroll
            for (int b = 0; b < NB; ++b)
#pragma unroll
                for (int j = 0; j < 4; ++j) nxt[b][j] = ((const f32x4*)(src + (size_t)(r + NB + b) * DM))[lane + 64 * j];
        }
        float s[NB], s2[NB];
#pragma unroll
        for (int b = 0; b < NB; ++b) { s[b] = 0.f;
#pragma unroll
            for (int j = 0; j < 4; ++j) s[b] += (cur[b][j].x + cur[b][j].y) + (cur[b][j].z + cur[b][j].w); }
#pragma unroll
        for (int o = 1; o < 64; o <<= 1)
#pragma unroll
            for (int b = 0; b < NB; ++b) s[b] += __shfl_xor(s[b], o);
#pragma unroll
        for (int b = 0; b < NB; ++b) { const float mean = s[b] * (1.f / DM); s2[b] = 0.f;
#pragma unroll
            for (int j = 0; j < 4; ++j) { cur[b][j] = cur[b][j] - mean; s2[b] += (cur[b][j].x * cur[b][j].x + cur[b][j].y * cur[b][j].y) + (cur[b][j].z * cur[b][j].z + cur[b][j].w * cur[b][j].w); } }
#pragma unroll
        for (int o = 1; o < 64; o <<= 1)
#pragma unroll
            for (int b = 0; b < NB; ++b) s2[b] += __shfl_xor(s2[b], o);
#pragma unroll
        for (int b = 0; b < NB; ++b) {
            const float rstd = 1.f / sqrtf(s2[b] * (1.f / DM) + LN_EPS);
            if (T && lane == 0) T[r + b] = (f32x2){s[b] * (1.f / DM), rstd};
#pragma unroll
            for (int j = 0; j < 4; ++j) {
                const f32x4 o = cur[b][j] * rstd * gv[j] + bv[j];
                if (dst) ((f32x4*)(dst + (size_t)(r + b) * DM))[lane + 64 * j] = o;
                if (dstb) { u32x2 w; w.x = pk2(o.x, o.y); w.y = pk2(o.z, o.w); ((u32x2*)(dstb + (size_t)(r + b) * DM))[lane + 64 * j] = w; }
            }
        }
#pragma unroll
        for (int b = 0; b < NB; ++b)
#pragma unroll
            for (int j = 0; j < 4; ++j) cur[b][j] = nxt[b][j];
    }
}

__device__ __forceinline__ void ln_panel_b(bf16_t* hb, float* outf, const float* gam, const float* bet) {
    int tid_ = threadIdx.x; asm volatile("" : "+v"(tid_));
    const int lane = tid_ & 63, wave = __builtin_amdgcn_readfirstlane(tid_ >> 6);
    constexpr int NB = 2;
    u32x4 nxt[NB][2];
    const int r0 = wave * 32;
#pragma unroll
    for (int b = 0; b < NB; ++b)
#pragma unroll
        for (int j = 0; j < 2; ++j) nxt[b][j] = ((const u32x4*)(hb + (size_t)(r0 + b) * DM))[lane + 64 * j];
    f32x4 gv[2][2], bv[2][2];
#pragma unroll
    for (int j = 0; j < 2; ++j)
#pragma unroll
        for (int q = 0; q < 2; ++q) { gv[j][q] = *(const f32x4*)(gam + 512 * j + 8 * lane + 4 * q); bv[j][q] = *(const f32x4*)(bet + 512 * j + 8 * lane + 4 * q); }
    for (int it = 0; it < 32 / NB; ++it) {
        const int r = r0 + it * NB;
        float v[NB][16];
#pragma unroll
        for (int b = 0; b < NB; ++b)
#pragma unroll
            for (int j = 0; j < 2; ++j)
#pragma unroll
                for (int k = 0; k < 4; ++k) { v[b][8 * j + 2 * k] = bflo(nxt[b][j][k]); v[b][8 * j + 2 * k + 1] = bfhi(nxt[b][j][k]); }
        if (it + 1 < 32 / NB) {
#pragma unroll
            for (int b = 0; b < NB; ++b)
#pragma unroll
                for (int j = 0; j < 2; ++j) nxt[b][j] = ((const u32x4*)(hb + (size_t)(r + NB + b) * DM))[lane + 64 * j];
        }
        float s[NB], s2[NB];
#pragma unroll
        for (int b = 0; b < NB; ++b) { s[b] = 0.f;
#pragma unroll
            for (int k = 0; k < 16; ++k) s[b] += v[b][k]; }
#pragma unroll
        for (int o = 1; o < 64; o <<= 1)
#pragma unroll
            for (int b = 0; b < NB; ++b) s[b] += __shfl_xor(s[b], o);
#pragma unroll
        for (int b = 0; b < NB; ++b) { const float mean = s[b] * (1.f / DM); s2[b] = 0.f;
#pragma unroll
            for (int k = 0; k < 16; ++k) { v[b][k] -= mean; s2[b] += v[b][k] * v[b][k]; } }
#pragma unroll
        for (int o = 1; o < 64; o <<= 1)
#pragma unroll
            for (int b = 0; b < NB; ++b) s2[b] += __shfl_xor(s2[b], o);
#pragma unroll
        for (int b = 0; b < NB; ++b) {
            const float rstd = 1.f / sqrtf(s2[b] * (1.f / DM) + LN_EPS);
#pragma unroll
            for (int j = 0; j < 2; ++j) {
                float o[8];
#pragma unroll
                for (int k = 0; k < 8; ++k) o[k] = v[b][8 * j + k] * rstd * gv[j][k >> 2][k & 3] + bv[j][k >> 2][k & 3];
                if (outf) { f32x4* op = (f32x4*)(outf + (size_t)(r + b) * DM + 512 * j + 8 * lane); op[0] = (f32x4){o[0], o[1], o[2], o[3]}; op[1] = (f32x4){o[4], o[5], o[6], o[7]}; }
                else { u32x4 w; w.x = pk2(o[0], o[1]); w.y = pk2(o[2], o[3]); w.z = pk2(o[4], o[5]); w.w = pk2(o[6], o[7]); ((u32x4*)(hb + (size_t)(r + b) * DM))[lane + 64 * j] = w; }
            }
        }
    }
}

__device__ __forceinline__ void prologue(CArgs& a, LAS unsigned char* lds, int panel, int G) {
    int tid_ = threadIdx.x; asm volatile("" : "+v"(tid_));
    const int lane = tid_ & 63, wave = __builtin_amdgcn_readfirstlane(tid_ >> 6);
    unsigned char* ws = a.ws;
    LAS float* scr = (LAS float*)(lds + wave * 17408);
    const int gw = panel * 8 + wave, NGW = G * 8;
    constexpr int I_IN = (DM / 64) * (DINP / 32), I_OUT = (DM / 64) * (DM / 32), I_1 = (DM / 64) * (DFF / 32), I_2 = (DFF / 64) * (DM / 32), I_G = (256 / 64) * (256 / 32);
    constexpr int I_L = I_IN + I_OUT + I_1 + I_2 + I_G;
    for (int it = gw; it < NLAYER * I_L; it += NGW) {
        const int l = it / I_L; int r = it % I_L;
        if (r < I_IN) { transpose_item<true>(a.in[3] + (size_t)l * DM * DIN, DM, DIN, DINP, (bf16_t*)(ws + WS_WIN) + (size_t)l * DINP * DM, scr, r, lane); continue; } r -= I_IN;
        if (r < I_OUT) { transpose_item(a.in[23] + (size_t)l * DM * DM, DM, DM, DM, (bf16_t*)(ws + WS_WOUT) + (size_t)l * DM * DM, scr, r, lane); continue; } r -= I_OUT;
        if (r < I_1) { transpose_item(a.in[26] + (size_t)l * DM * DFF, DM, DFF, DFF, (bf16_t*)(ws + WS_W1) + (size_t)l * DFF * DM, scr, r, lane); continue; } r -= I_1;
        if (r < I_2) { transpose_item(a.in[27] + (size_t)l * DFF * DM, DFF, DM, DM, (bf16_t*)(ws + WS_W2) + (size_t)l * DM * DFF, scr, r, lane); continue; } r -= I_2;
        transpose_item(a.in[12] + (size_t)l * 256 * 256, 256, 256, 256, (bf16_t*)(ws + WS_WGLU) + (size_t)l * 256 * 256, scr, r, lane);
    }
    for (int it = NGW - 1 - gw; it < NLAYER * 16 * 5; it += NGW) {
        const int l = it / (16 * 5), r = it % (16 * 5), g = r / 5, d = r % 5;
        if (d < 4) s5_prep_k(a, ws, scr, l, g, d, lane); else s5_prep_vw(a, ws, l, g, lane);
    }
    for (int e = gw * 64 + lane; e < NLAYER * 2 * 8 * 1024; e += NGW * 64) {
        const int i = e & 31, j = (e >> 5) & 31, h = (e >> 10) & 7, which = (e >> 13) & 1, l = e >> 14;
        const float* w = a.in[which ? 20 : 18] + (size_t)(l * 8 + h) * 1024;
        ((bf16_t*)(ws + WS_LRUW))[e] = (bf16_t)f2bf(w[i * 32 + j]);
    }
    __syncthreads();
    ln_panel(a.in[0] + (size_t)panel * 256 * DM, nullptr, (bf16_t*)(ws + WS_HB) + (size_t)panel * 256 * DM, a.in[1], a.in[2], nullptr);
}

__device__ __forceinline__ void gz_phase(CArgs& a, int l, int panel) {
    int tid_ = threadIdx.x; asm volatile("" : "+v"(tid_));
    const int lane = tid_ & 63, wave = __builtin_amdgcn_readfirstlane(tid_ >> 6), fr = lane & 15, fq = lane >> 4;
    unsigned char* ws = a.ws;
    const bf16_t* Hb = (const bf16_t*)(ws + WS_HB) + (size_t)panel * 256 * DM + (size_t)(wave * 32 + fr) * DM + 8 * fq;
    const bf16_t* Wt = (const bf16_t*)(ws + WS_WIN) + (size_t)l * DINP * DM + (size_t)(C_GZ + fr) * DM + 8 * fq;
    f32x4 acc0 = (f32x4){0.f, 0.f, 0.f, 0.f}, acc1 = acc0;
#pragma unroll 8
    for (int ks = 0; ks < 32; ++ks) {
        const bf16x8 wf = *(const bf16x8*)(Wt + 32 * ks);
        acc0 = mfma16(wf, *(const bf16x8*)(Hb + 32 * ks), acc0);
        acc1 = mfma16(wf, *(const bf16x8*)(Hb + 16 * DM + 32 * ks), acc1);
    }
    unsigned char* Zp = ws + WS_PANEL + (size_t)panel * PANEL_BYTES + P_Z;
    u32x2 w0, w1; w0.x = pk2(acc0[0], acc0[1]); w0.y = pk2(acc0[2], acc0[3]); w1.x = pk2(acc1[0], acc1[1]); w1.y = pk2(acc1[2], acc1[3]);
    *(u32x2*)(Zp + (size_t)(wave * 32 + fr) * ZROWB + (C_GZ + 4 * fq) * 2) = w0;
    *(u32x2*)(Zp + (size_t)(wave * 32 + 16 + fr) * ZROWB + (C_GZ + 4 * fq) * 2) = w1;
}

template <int PASS>
__device__ __forceinline__ void lru_pass(CArgs& a, int l, int panel) {
    int tid_ = threadIdx.x; asm volatile("" : "+v"(tid_));
    const int lane = tid_ & 63, wave = tid_ >> 6;
    unsigned char* ws = a.ws;
    const int fr = lane & 15, fq = lane >> 4, h = wave, ch0 = h * 32 + 8 * fq;
    float cw[4][8], cb[8], br[8], bi[8], sp[8];
#pragma unroll
    for (int c = 0; c < 8; ++c) {
#pragma unroll
        for (int j = 0; j < 4; ++j) cw[j][c] = a.in[16][(size_t)(l * 4 + j) * 256 + ch0 + c];
        cb[c] = a.in[17][l * 256 + ch0 + c]; br[c] = a.in[19][l * 256 + ch0 + c]; bi[c] = a.in[21][l * 256 + ch0 + c];
        const float x = -a.in[22][l * 256 + ch0 + c];
        sp[c] = 8.f * (fmaxf(x, 0.f) + log1pf(expf(-fabsf(x))));
    }
    bf16x8 wrf[2], wif[2];
#pragma unroll
    for (int mt = 0; mt < 2; ++mt) { const int j = 8 * (fr >> 2) + 4 * mt + (fr & 3);
        wrf[mt] = *(const bf16x8*)((const bf16_t*)(ws + WS_LRUW) + (size_t)((l * 2 + 0) * 8 + h) * 1024 + j * 32 + 8 * fq);
        wif[mt] = *(const bf16x8*)((const bf16_t*)(ws + WS_LRUW) + (size_t)((l * 2 + 1) * 8 + h) * 1024 + j * 32 + 8 * fq); }
    const unsigned char* Zp = ws + WS_PANEL + (size_t)panel * PANEL_BYTES + P_Z;
    const unsigned char* Zprev = Zp - PANEL_BYTES;
    unsigned char* MIX = ws + WS_PANEL + (size_t)panel * PANEL_BYTES + P_MIX;
    const bool seq_start = (panel & 31) == 0;
    float hin[8], atot[8];
#pragma unroll
    for (int c = 0; c < 8; ++c) { hin[c] = (PASS == 2) ? ((const float*)(ws + WS_LRUB))[(size_t)panel * 256 + ch0 + c] : 0.f; atot[c] = 1.f; }
    u32x4 xn[4], gn = (u32x4){0u, 0u, 0u, 0u};
#define LRU_LOAD(tile_) do { const int t_ = (tile_) * 16 + fr; _Pragma("unroll") for (int j = 0; j < 4; ++j) { const int tt = t_ - 3 + j; xn[j] = (u32x4){0u, 0u, 0u, 0u}; \
            if (tt >= 0) xn[j] = *(const u32x4*)(Zp + (size_t)tt * ZROWB + (C_LX + ch0) * 2); \
            else if (!seq_start) xn[j] = *(const u32x4*)(Zprev + (size_t)(256 + tt) * ZROWB + (C_LX + ch0) * 2); } \
        if (PASS == 2) gn = *(const u32x4*)(Zp + (size_t)t_ * ZROWB + (C_LG + ch0) * 2); } while (0)
    LRU_LOAD(0);
    for (int tile = 0; tile < 16; ++tile) {
        const int t = tile * 16 + fr;
        float xc[8];
#pragma unroll
        for (int c = 0; c < 8; ++c) xc[c] = cb[c];
#pragma unroll
        for (int j = 0; j < 4; ++j) {
            const u32x4 xv = xn[j];
#pragma unroll
            for (int k = 0; k < 4; ++k) { xc[2 * k] += cw[j][2 * k] * bflo(xv[k]); xc[2 * k + 1] += cw[j][2 * k + 1] * bfhi(xv[k]); }
        }
        const u32x4 gv = gn;
        if (tile + 1 < 16) LRU_LOAD(tile + 1);
        u32x4 xp; xp.x = pk2(xc[0], xc[1]); xp.y = pk2(xc[2], xc[3]); xp.z = pk2(xc[4], xc[5]); xp.w = pk2(xc[6], xc[7]);
        const bf16x8 xcb = __builtin_bit_cast(bf16x8, xp);
        f32x4 ar[2], ai[2];
#pragma unroll
        for (int mt = 0; mt < 2; ++mt) { ar[mt] = mfma16(wrf[mt], xcb, (f32x4){0.f, 0.f, 0.f, 0.f}); ai[mt] = mfma16(wif[mt], xcb, (f32x4){0.f, 0.f, 0.f, 0.f}); }
        float A[8], B[8];
#pragma unroll
        for (int c = 0; c < 8; ++c) {
            const float gr = sigmoidf_(ar[c >> 2][c & 3] + br[c]), gi = sigmoidf_(ai[c >> 2][c & 3] + bi[c]);
            const float la = -gr * sp[c];
            const float x2 = 2.f * la;
            const float om = -x2 * (1.f + x2 * (0.5f + x2 * (0.16666667f + x2 * (0.041666668f + x2 * (0.0083333338f + x2 * 0.0013888889f)))));
            A[c] = fexp(la); B[c] = __builtin_amdgcn_sqrtf(fmaxf(om, 0.f)) * (gi * xc[c]);
        }
#pragma unroll
        for (int s = 1; s < 16; s <<= 1) {
#pragma unroll
            for (int c = 0; c < 8; ++c) { const float ap = __shfl_up(A[c], s, 16), bp = __shfl_up(B[c], s, 16);
                if (fr >= s) { B[c] = A[c] * bp + B[c]; A[c] = A[c] * ap; } }
        }
        if (PASS == 2) {
            float o[8];
#pragma unroll
            for (int k = 0; k < 4; ++k) { o[2 * k] = (A[2 * k] * hin[2 * k] + B[2 * k]) * gelu_tanh(bflo(gv[k])); o[2 * k + 1] = (A[2 * k + 1] * hin[2 * k + 1] + B[2 * k + 1]) * gelu_tanh(bfhi(gv[k])); }
            u32x4 w; w.x = pk2(o[0], o[1]); w.y = pk2(o[2], o[3]); w.z = pk2(o[4], o[5]); w.w = pk2(o[6], o[7]);
            *(u32x4*)(MIX + (size_t)t * 2048 + (768 + ch0) * 2) = w;
        }
        if (PASS == 1) {
            u32x4 w0, w1; w0.x = pk2(A[0], B[0]); w0.y = pk2(A[1], B[1]); w0.z = pk2(A[2], B[2]); w0.w = pk2(A[3], B[3]); w1.x = pk2(A[4], B[4]); w1.y = pk2(A[5], B[5]); w1.z = pk2(A[6], B[6]); w1.w = pk2(A[7], B[7]);
            u32x4* abp = (u32x4*)(ws + WS_LRUAB + (((size_t)panel * 256 + t) * 256 + ch0) * 4); abp[0] = w0; abp[1] = w1;
        }
        float a15[8], b15[8];
#pragma unroll
        for (int c = 0; c < 8; ++c) { a15[c] = __shfl(A[c], 15, 16); b15[c] = __shfl(B[c], 15, 16); hin[c] = a15[c] * hin[c] + b15[c]; atot[c] *= a15[c]; }
        if (PASS == 1 && fr == 0) {
            f32x4* cp = (f32x4*)(ws + WS_LRUC + (((size_t)panel * 16 + tile) * 256 + ch0) * 8);
            cp[0] = (f32x4){a15[0], b15[0], a15[1], b15[1]}; cp[1] = (f32x4){a15[2], b15[2], a15[3], b15[3]}; cp[2] = (f32x4){a15[4], b15[4], a15[5], b15[5]}; cp[3] = (f32x4){a15[6], b15[6], a15[7], b15[7]};
        }
    }
    if (PASS == 1 && fr == 0) {
#pragma unroll
        for (int c = 0; c < 8; ++c) { ((float*)(ws + WS_LRUA))[(size_t)panel * 256 + ch0 + c] = atot[c]; ((float*)(ws + WS_LRUB))[(size_t)panel * 256 + ch0 + c] = hin[c]; }
    }
}

__device__ __forceinline__ void lru_apply(CArgs& a, int l, int panel) {
    int tid_ = threadIdx.x; asm volatile("" : "+v"(tid_));
    const int lane = tid_ & 63, wave = tid_ >> 6;
    unsigned char* ws = a.ws;
    const int fr = lane & 15, fq = lane >> 4, ch0 = wave * 32 + 8 * fq;
    const unsigned char* Zp = ws + WS_PANEL + (size_t)panel * PANEL_BYTES + P_Z;
    unsigned char* MIX = ws + WS_PANEL + (size_t)panel * PANEL_BYTES + P_MIX;
    float hin[8];
#pragma unroll
    for (int c = 0; c < 8; ++c) hin[c] = ((const float*)(ws + WS_LRUB))[(size_t)panel * 256 + ch0 + c];
    u32x4 abn[2], gn; f32x4 cn[4];
#define LRU2_LOAD(tile_) do { const int t_ = (tile_) * 16 + fr; const u32x4* abp_ = (const u32x4*)(ws + WS_LRUAB + (((size_t)panel * 256 + t_) * 256 + ch0) * 4); abn[0] = abp_[0]; abn[1] = abp_[1]; \
        gn = *(const u32x4*)(Zp + (size_t)t_ * ZROWB + (C_LG + ch0) * 2); \
        const f32x4* cp_ = (const f32x4*)(ws + WS_LRUC + (((size_t)panel * 16 + (tile_)) * 256 + ch0) * 8); cn[0] = cp_[0]; cn[1] = cp_[1]; cn[2] = cp_[2]; cn[3] = cp_[3]; } while (0)
    LRU2_LOAD(0);
    for (int tile = 0; tile < 16; ++tile) {
        const int t = tile * 16 + fr;
        const u32x4 ab0 = abn[0], ab1 = abn[1], gv = gn; const f32x4 c0 = cn[0], c1 = cn[1], c2 = cn[2], c3 = cn[3];
        if (tile + 1 < 16) LRU2_LOAD(tile + 1);
        float o[8];
#pragma unroll
        for (int k = 0; k < 4; ++k) {
            o[k] = bflo(ab0[k]) * hin[k] + bfhi(ab0[k]); o[4 + k] = bflo(ab1[k]) * hin[4 + k] + bfhi(ab1[k]);
        }
#pragma unroll
        for (int k = 0; k < 4; ++k) { o[2 * k] *= gelu_tanh(bflo(gv[k])); o[2 * k + 1] *= gelu_tanh(bfhi(gv[k])); }
        u32x4 w; w.x = pk2(o[0], o[1]); w.y = pk2(o[2], o[3]); w.z = pk2(o[4], o[5]); w.w = pk2(o[6], o[7]);
        *(u32x4*)(MIX + (size_t)t * 2048 + (768 + ch0) * 2) = w;
        hin[0] = c0[0] * hin[0] + c0[1]; hin[1] = c0[2] * hin[1] + c0[3]; hin[2] = c1[0] * hin[2] + c1[1]; hin[3] = c1[2] * hin[3] + c1[3];
        hin[4] = c2[0] * hin[4] + c2[1]; hin[5] = c2[2] * hin[5] + c2[3]; hin[6] = c3[0] * hin[6] + c3[1]; hin[7] = c3[2] * hin[7] + c3[3];
    }
#undef LRU2_LOAD
}

template <int PASS>
__device__ __forceinline__ void s5_pass(CArgs& a, LAS unsigned char* lds, int l, int panel) {
    int tid_ = threadIdx.x; asm volatile("" : "+v"(tid_));
    const int lane = tid_ & 63, wave = __builtin_amdgcn_readfirstlane(tid_ >> 6);
    unsigned char* ws = a.ws;
    const int fr = lane & 15, fq = lane >> 4;
    LAS float* hl = (LAS float*)(lds + wave * 12288);
    LAS bf16_t* xh = (LAS bf16_t*)(lds + wave * 12288 + 8192);
    const unsigned char* Zp = ws + WS_PANEL + (size_t)panel * PANEL_BYTES + P_Z;
    unsigned char* YS5 = ws + WS_PANEL + (size_t)panel * PANEL_BYTES + P_YS5;
    for (int gi = 0; gi < 2; ++gi) {
        const int g = 2 * wave + gi;
        const bf16_t* Wg = (const bf16_t*)(ws + WS_S5W) + (size_t)(l * 16 + g) * 128 * 64;
        const bf16_t* Mg = (const bf16_t*)(ws + WS_S5M) + (size_t)(l * 16 + g) * 64 * 192;
        bf16x8 wf[8][2];
#pragma unroll
        for (int mt = 0; mt < 8; ++mt)
#pragma unroll
            for (int ks = 0; ks < 2; ++ks) wf[mt][ks] = *(const bf16x8*)(Wg + (size_t)(16 * mt + fr) * 64 + 32 * ks + 8 * fq);
        bf16x8 mf[4][4];
        f32x4 dsk = (f32x4){0.f, 0.f, 0.f, 0.f};
        if (PASS == 2) {
#pragma unroll
            for (int mt = 0; mt < 4; ++mt)
#pragma unroll
                for (int ks = 0; ks < 4; ++ks) mf[mt][ks] = *(const bf16x8*)(Mg + (size_t)(16 * mt + fr) * 192 + 64 + 32 * ks + 8 * fq);
            dsk = *(const f32x4*)(a.in[11] + l * 256 + g * 16 + 4 * fq);
        }
        const float* Ap = (const float*)(ws + WS_S5A) + ((size_t)(l * 16 + g) * 64 + lane) * 4;
        const float a4r = Ap[0], a4i = Ap[1];
        float* Hg = (float*)(ws + WS_S5H) + ((size_t)panel * 16 + g) * 128 + 2 * lane;
        float Hr = 0.f, Hi = 0.f;
        if (PASS == 2) { Hr = Hg[0]; Hi = Hg[1]; }
#pragma unroll 1
        for (int nt = 0; nt < 4; ++nt) {
            bf16x8 xf[2];
#pragma unroll
            for (int ks = 0; ks < 2; ++ks) xf[ks] = *(const bf16x8*)(Zp + (size_t)(64 * nt + 4 * fr + 2 * ks + (fq >> 1)) * ZROWB + (C_S5U + g * 16 + (fq & 1) * 8) * 2);
#pragma unroll
            for (int mt = 0; mt < 8; ++mt) {
                f32x4 acc = mfma16(wf[mt][0], xf[0], (f32x4){0.f, 0.f, 0.f, 0.f});
                acc = mfma16(wf[mt][1], xf[1], acc);
                *(LAS f32x4*)(hl + fr * 128 + 16 * mt + 4 * fq) = acc;
            }
            lds_fence();
            for (int j = 0; j < 16; ++j) {
                if (PASS == 2) *(LAS unsigned*)(xh + j * 128 + 2 * lane) = pk2(Hr, Hi);
                const f32x2 lc = *(LAS f32x2*)(hl + j * 128 + 2 * lane);
                const float nr = a4r * Hr - a4i * Hi + lc.x, ni = a4r * Hi + a4i * Hr + lc.y;
                Hr = nr; Hi = ni;
            }
            lds_fence();
            if (PASS == 2) {
                bf16x8 xhf[4];
#pragma unroll
                for (int k4 = 0; k4 < 4; ++k4) xhf[k4] = *(const LAS bf16x8*)(xh + fr * 128 + 32 * k4 + 8 * fq);
#pragma unroll
                for (int mt = 0; mt < 4; ++mt) {
                    f32x4 acc = (f32x4){0.f, 0.f, 0.f, 0.f};
#pragma unroll
                    for (int ks = 0; ks < 2; ++ks) if (2 * ks <= mt) acc = mfma16(*(const bf16x8*)(Mg + (size_t)(16 * mt + fr) * 192 + 32 * ks + 8 * fq), xf[ks], acc);
#pragma unroll
                    for (int k4 = 0; k4 < 4; ++k4) acc = mfma16(mf[mt][k4], xhf[k4], acc);
                    const int tok = (16 * nt + fr) * 4 + mt, ch = g * 16 + 4 * fq;
                    const u32x2 uv = *(const u32x2*)(Zp + (size_t)tok * ZROWB + (C_S5U + ch) * 2);
                    const float y0 = gelu_tanh(acc[0] + dsk[0] * bflo(uv.x)), y1 = gelu_tanh(acc[1] + dsk[1] * bfhi(uv.x));
                    const float y2 = gelu_tanh(acc[2] + dsk[2] * bflo(uv.y)), y3 = gelu_tanh(acc[3] + dsk[3] * bfhi(uv.y));
                    u32x2 w; w.x = pk2(y0, y1); w.y = pk2(y2, y3);
                    *(u32x2*)(YS5 + (size_t)tok * 512 + ch * 2) = w;
                }
            }
            lds_fence();
        }
        if (PASS == 1) { Hg[0] = Hr; Hg[1] = Hi; }
    }
}

constexpr int GL_QE = 0, GL_KE = 9216, GL_KDT = 18432, GL_VT = 27648, GL_SC = 46080, GL_ST = 55296, GL_GP = 73728, GL_SS = 75776, GL_DK = 76288, GL_X = 77824;
constexpr int GXS = 68;
constexpr int GRS = 144;
template <int PASS>
__device__ __forceinline__ void gla_pass(CArgs& a, LAS unsigned char* lds, int l, int panel) {
    int tid = threadIdx.x; asm volatile("" : "+v"(tid));
    const int lane = tid & 63, wave = tid >> 6;
    unsigned char* ws = a.ws;
    const int fr = lane & 15, fq = lane >> 4;
    const int d_ = lane, tq = wave;
    const int e_ = tid & 127, tq4 = tid >> 7;
    const int wq = wave & 3, wh = wave >> 2;
    const unsigned char* Zp = ws + WS_PANEL + (size_t)panel * PANEL_BYTES + P_Z;
    unsigned char* MIX = ws + WS_PANEL + (size_t)panel * PANEL_BYTES + P_MIX;
    LAS float* GP = (LAS float*)(lds + GL_GP); LAS float* SS = (LAS float*)(lds + GL_SS); LAS float* DK = (LAS float*)(lds + GL_DK);
    u32x4 pgz[2]; bf16_t pq[8], pk[8]; unsigned pv[8]; u32x2 pr[4];
#define GLA_LOAD(it_) do { const int h_ = (it_) >> 2, row0_ = ((it_) & 3) * 64; \
        _Pragma("unroll") for (int i = 0; i < 2; ++i) { pgz[i] = (u32x4){0u, 0u, 0u, 0u}; if (fq < 2) pgz[i] = *(const u32x4*)(Zp + (size_t)(row0_ + 16 * (2 * wh + i) + fr) * ZROWB + (C_GZ + 8 * fq) * 2); } \
        _Pragma("unroll") for (int i = 0; i < 8; ++i) { const unsigned char* zr = Zp + (size_t)(row0_ + tq * 8 + i) * ZROWB; \
            if (PASS == 2) pq[i] = *(const bf16_t*)(zr + (C_Q + h_ * 64 + d_) * 2); pk[i] = *(const bf16_t*)(zr + (C_K + h_ * 64 + d_) * 2); } \
        _Pragma("unroll") for (int i = 0; i < 8; ++i) pv[i] = *(const unsigned*)(Zp + (size_t)(row0_ + tq * 8 + i) * ZROWB + (C_V + h_ * 128 + 2 * d_) * 2); \
        if (PASS == 2) { _Pragma("unroll") for (int k = 0; k < 4; ++k) pr[k] = *(const u32x2*)(Zp + (size_t)(row0_ + 16 * wq + fr) * ZROWB + (C_R + h_ * 128 + 16 * (wh * 4 + k) + 4 * fq) * 2); } } while (0)
    GLA_LOAD(0);
    float bg = 0.f; f32x4 st[4]; float dprod = 1.f;
#pragma unroll
    for (int k = 0; k < 4; ++k) st[k] = (f32x4){0.f, 0.f, 0.f, 0.f};
    float* Sg = (float*)(ws + WS_GLAS) + ((size_t)panel * 4) * 8192;
    bf16x8 wfr = (bf16x8){0, 0, 0, 0, 0, 0, 0, 0};
#define GLA_WFRAG(h_) do { u32x4 w_ = (u32x4){0u, 0u, 0u, 0u}; if (fq < 2) { const float* wp_ = a.in[13] + (size_t)(l * 16 + 8 * fq) * 256 + (h_) * 64 + 16 * wq + fr; \
        w_.x = pk2(wp_[0], wp_[256]); w_.y = pk2(wp_[512], wp_[768]); w_.z = pk2(wp_[1024], wp_[1280]); w_.w = pk2(wp_[1536], wp_[1792]); } wfr = __builtin_bit_cast(bf16x8, w_); } while (0)
#define GLA_XTILE(g0_, g1_) do { const f32x4 x0_ = mfma16(wfr, __builtin_bit_cast(bf16x8, g0_), (f32x4){0.f, 0.f, 0.f, 0.f}), x1_ = mfma16(wfr, __builtin_bit_cast(bf16x8, g1_), (f32x4){0.f, 0.f, 0.f, 0.f}); \
        *(LAS f32x4*)(lds + GL_X + ((16 * (2 * wh) + fr) * GXS + 16 * wq + 4 * fq) * 4) = x0_; *(LAS f32x4*)(lds + GL_X + ((16 * (2 * wh + 1) + fr) * GXS + 16 * wq + 4 * fq) * 4) = x1_; } while (0)
    f32x4 ngv[4];
#pragma unroll
    for (int k = 0; k < 4; ++k) ngv[k] = (PASS == 2) ? *(const f32x4*)(a.in[15] + l * 128 + 16 * (wh * 4 + k) + 4 * fq) : (f32x4){0.f, 0.f, 0.f, 0.f};
    GLA_WFRAG(0);
    GLA_XTILE(pgz[0], pgz[1]);
    __syncthreads();
#pragma unroll 1
    for (int it = 0; it < 16; ++it) {
        const int h = it >> 2, c = it & 3, row0 = c * 64;
        if (c == 0) {
            bg = a.in[14][l * 256 + h * 64 + d_];
            Sg = (float*)(ws + WS_GLAS) + ((size_t)panel * 4 + h) * 8192;
#pragma unroll
            for (int k = 0; k < 4; ++k) {
                const int et = wh * 4 + k;
#pragma unroll
                for (int r = 0; r < 4; ++r) {
                    const int e = 16 * et + 4 * fq + r, d = 16 * wq + fr;
                    if (PASS == 2) { const float v = Sg[e * 64 + d]; st[k][r] = v; *(LAS bf16_t*)(lds + GL_ST + e * GRS + d * 2) = (bf16_t)f2bf(v); }
                    else st[k][r] = 0.f;
                }
            }
            dprod = 1.f;
        }
        float qv[8], kv[8]; unsigned vpk[8]; u32x2 rvv[4];
#pragma unroll
        for (int i = 0; i < 8; ++i) { qv[i] = (PASS == 2) ? bf1(pq[i]) : 0.f; kv[i] = bf1(pk[i]); vpk[i] = pv[i]; }
#pragma unroll
        for (int k = 0; k < 4; ++k) rvv[k] = pr[k];
        if (it + 1 < 16) GLA_LOAD(it + 1);
        float gl[8];
#pragma unroll
        for (int i = 0; i < 8; ++i) {
            const float x = bg + *(const LAS float*)(lds + GL_X + ((tq * 8 + i) * GXS + d_) * 4);
            const float ls = fminf(x, 0.f) - flog(1.f + fexp(-fabsf(x)));
            gl[i] = ls * 0.0625f + (i ? gl[i - 1] : 0.f);
        }
        GP[tq * 64 + d_] = gl[7];
        __syncthreads();
        float off = 0.f, tot = 0.f;
#pragma unroll
        for (int k = 0; k < 8; ++k) { const float v = GP[k * 64 + d_]; tot += v; if (k < tq) off += v; }
        float kd[8];
#pragma unroll
        for (int i = 0; i < 8; ++i) {
            const float bc = off + gl[i];
            if (PASS == 2) {
                const float eb = fexp(bc);
                const unsigned qk = pk2(qv[i] * 0.125f * eb, kv[i] * __builtin_amdgcn_rcpf(eb));
                *(LAS bf16_t*)(lds + GL_QE + (tq * 8 + i) * GRS + d_ * 2) = (bf16_t)(qk & 0xffffu);
                *(LAS bf16_t*)(lds + GL_KE + (tq * 8 + i) * GRS + d_ * 2) = (bf16_t)(qk >> 16);
            }
            kd[i] = kv[i] * fexp(tot - bc);
        }
        { u32x4 w; w.x = pk2(kd[0], kd[1]); w.y = pk2(kd[2], kd[3]); w.z = pk2(kd[4], kd[5]); w.w = pk2(kd[6], kd[7]);
          *(LAS u32x4*)(lds + GL_KDT + d_ * GRS + tq * 16) = w; }
        if (tq == 0) DK[d_] = fexp(tot);
        {
            u32x4 w0, w1;
            w0.x = __builtin_amdgcn_perm(vpk[1], vpk[0], 0x05040100u); w0.y = __builtin_amdgcn_perm(vpk[3], vpk[2], 0x05040100u); w0.z = __builtin_amdgcn_perm(vpk[5], vpk[4], 0x05040100u); w0.w = __builtin_amdgcn_perm(vpk[7], vpk[6], 0x05040100u);
            w1.x = __builtin_amdgcn_perm(vpk[1], vpk[0], 0x07060302u); w1.y = __builtin_amdgcn_perm(vpk[3], vpk[2], 0x07060302u); w1.z = __builtin_amdgcn_perm(vpk[5], vpk[4], 0x07060302u); w1.w = __builtin_amdgcn_perm(vpk[7], vpk[6], 0x07060302u);
            *(LAS u32x4*)(lds + GL_VT + (2 * d_) * GRS + tq * 16) = w0; *(LAS u32x4*)(lds + GL_VT + (2 * d_ + 1) * GRS + tq * 16) = w1; }
        __syncthreads();
        f32x4 o[4];
        if (PASS == 2) {
#pragma unroll
            for (int jj = 0; jj < 2; ++jj) {
                const int jt = 2 * wh + jj;
                f32x4 acc = (f32x4){0.f, 0.f, 0.f, 0.f};
#pragma unroll
                for (int ks = 0; ks < 2; ++ks) acc = mfma16(*(const LAS bf16x8*)(lds + GL_KE + (16 * jt + fr) * GRS + (32 * ks + 8 * fq) * 2),
                                                            *(const LAS bf16x8*)(lds + GL_QE + (16 * wq + fr) * GRS + (32 * ks + 8 * fq) * 2), acc);
                const int i = 16 * wq + fr, j0 = 16 * jt + 4 * fq;
                u32x2 w; w.x = pk2(j0 <= i ? acc[0] : 0.f, j0 + 1 <= i ? acc[1] : 0.f); w.y = pk2(j0 + 2 <= i ? acc[2] : 0.f, j0 + 3 <= i ? acc[3] : 0.f);
                *(LAS u32x2*)(lds + GL_SC + i * GRS + j0 * 2) = w;
            }
            __syncthreads();
            float ss = 0.f;
#pragma unroll
            for (int k = 0; k < 4; ++k) {
                const int et = wh * 4 + k;
                f32x4 acc = (f32x4){0.f, 0.f, 0.f, 0.f};
#pragma unroll
                for (int ks = 0; ks < 2; ++ks) {
                    if (ks == 0 || wq >= 2) acc = mfma16(*(const LAS bf16x8*)(lds + GL_VT + (16 * et + fr) * GRS + (32 * ks + 8 * fq) * 2),
                                                         *(const LAS bf16x8*)(lds + GL_SC + (16 * wq + fr) * GRS + (32 * ks + 8 * fq) * 2), acc);
                }
#pragma unroll
                for (int ks = 0; ks < 2; ++ks) acc = mfma16(*(const LAS bf16x8*)(lds + GL_ST + (16 * et + fr) * GRS + (32 * ks + 8 * fq) * 2),
                                                            *(const LAS bf16x8*)(lds + GL_QE + (16 * wq + fr) * GRS + (32 * ks + 8 * fq) * 2), acc);
                o[k] = acc; ss += (acc[0] * acc[0] + acc[1] * acc[1]) + (acc[2] * acc[2] + acc[3] * acc[3]);
            }
            ss += __shfl_xor(ss, 16); ss += __shfl_xor(ss, 32);
            if (fq == 0) SS[(16 * wq + fr) * 2 + wh] = ss;
        }
        {
            const float dk = DK[16 * wq + fr];
            dprod *= dk;
#pragma unroll
            for (int k = 0; k < 4; ++k) {
                const int et = wh * 4 + k;
                f32x4 acc = st[k] * dk;
#pragma unroll
                for (int ks = 0; ks < 2; ++ks) acc = mfma16(*(const LAS bf16x8*)(lds + GL_VT + (16 * et + fr) * GRS + (32 * ks + 8 * fq) * 2),
                                                            *(const LAS bf16x8*)(lds + GL_KDT + (16 * wq + fr) * GRS + (32 * ks + 8 * fq) * 2), acc);
                st[k] = acc;
            }
        }
        if (it + 1 < 16) {
            if (c == 3) GLA_WFRAG(h + 1);
            GLA_XTILE(pgz[0], pgz[1]);
        }
        __syncthreads();
        if (PASS == 2) {
            const int i = 16 * wq + fr;
            const float rs = rsqrtf((SS[i * 2] + SS[i * 2 + 1]) * (1.f / 128.f) + 1e-6f);
#pragma unroll
            for (int k = 0; k < 4; ++k) {
                const int e0 = 16 * (wh * 4 + k) + 4 * fq;
                const f32x4 ng = ngv[k];
                const u32x2 rv = rvv[k];
                const float r0 = bflo(rv.x), r1 = bfhi(rv.x), r2 = bflo(rv.y), r3 = bfhi(rv.y);
                u32x2 w; w.x = pk2(o[k][0] * rs * ng[0] * r0 * sigmoidf_(r0), o[k][1] * rs * ng[1] * r1 * sigmoidf_(r1));
                w.y = pk2(o[k][2] * rs * ng[2] * r2 * sigmoidf_(r2), o[k][3] * rs * ng[3] * r3 * sigmoidf_(r3));
                *(u32x2*)(MIX + (size_t)(row0 + i) * 2048 + (256 + h * 128 + e0) * 2) = w;
                { const unsigned s01 = pk2(st[k][0], st[k][1]), s23 = pk2(st[k][2], st[k][3]);
                  *(LAS bf16_t*)(lds + GL_ST + (e0 + 0) * GRS + (16 * wq + fr) * 2) = (bf16_t)(s01 & 0xffffu); *(LAS bf16_t*)(lds + GL_ST + (e0 + 1) * GRS + (16 * wq + fr) * 2) = (bf16_t)(s01 >> 16);
                  *(LAS bf16_t*)(lds + GL_ST + (e0 + 2) * GRS + (16 * wq + fr) * 2) = (bf16_t)(s23 & 0xffffu); *(LAS bf16_t*)(lds + GL_ST + (e0 + 3) * GRS + (16 * wq + fr) * 2) = (bf16_t)(s23 >> 16); }
            }
        }
        if (c == 3) {
            if (PASS == 1) {
#pragma unroll
                for (int k = 0; k < 4; ++k)
#pragma unroll
                    for (int r = 0; r < 4; ++r) Sg[(16 * (wh * 4 + k) + 4 * fq + r) * 64 + 16 * wq + fr] = st[k][r];
                if (wh == 0 && fq == 0) ((float*)(ws + WS_GLAD))[((size_t)panel * 4 + h) * 64 + 16 * wq + fr] = dprod;
            }
            __syncthreads();
        }
    }
#undef GLA_LOAD
#undef GLA_WFRAG
#undef GLA_XTILE
}

__device__ __forceinline__ void scan_phase(CArgs& a, int l) {
    int tid = threadIdx.x; asm volatile("" : "+v"(tid));
    unsigned char* ws = a.ws;
    const int gt = blockIdx.x * 512 + tid;
    for (int idx = gt; idx < 8 * 32768; idx += 131072) {
        const int b = idx >> 15, r = idx & 32767, hh = r >> 13, d = r & 63;
        float* S = (float*)(ws + WS_GLAS) + (size_t)(b * 32) * 32768 + r;
        const float* D = (const float*)(ws + WS_GLAD) + (size_t)(b * 32) * 256 + hh * 64 + d;
        float loc[32], dec[32];
#pragma unroll
        for (int s = 0; s < 32; ++s) { loc[s] = S[(size_t)s * 32768]; dec[s] = D[(size_t)s * 256]; }
        float run = 0.f;
#pragma unroll
        for (int s = 0; s < 32; ++s) { S[(size_t)s * 32768] = run; run = dec[s] * run + loc[s]; }
    }
    if (gt < 2048) {
        const int b = gt >> 8, ch = gt & 255;
        float* B = (float*)(ws + WS_LRUB) + (size_t)(b * 32) * 256 + ch; const float* A = (const float*)(ws + WS_LRUA) + (size_t)(b * 32) * 256 + ch;
        float loc[32], dec[32];
#pragma unroll
        for (int s = 0; s < 32; ++s) { loc[s] = B[s * 256]; dec[s] = A[s * 256]; }
        float run = 0.f;
#pragma unroll
        for (int s = 0; s < 32; ++s) { B[s * 256] = run; run = dec[s] * run + loc[s]; }
    } else if (gt >= 4096 && gt < 4096 + 8192) {
        const int q = gt - 4096, b = q >> 10, g = (q >> 6) & 15, p = q & 63;
        const float* Ap = (const float*)(ws + WS_S5A) + ((size_t)(l * 16 + g) * 64 + p) * 4;
        const float ar = Ap[2], ai = Ap[3];
        float* H = (float*)(ws + WS_S5H) + ((size_t)(b * 32) * 16 + g) * 128 + 2 * p;
        float rr = 0.f, ri = 0.f;
        f32x2 hv[32];
#pragma unroll
        for (int s = 0; s < 32; ++s) hv[s] = *(const f32x2*)(H + (size_t)s * 2048);
#pragma unroll
        for (int s = 0; s < 32; ++s) { *(f32x2*)(H + (size_t)s * 2048) = (f32x2){rr, ri};
            const float nr = ar * rr - ai * ri + hv[s].x, ni = ar * ri + ai * rr + hv[s].y; rr = nr; ri = ni; }
    }
}

#define XB_TMO      128
#define XB_XCNT(j)  (256  + 64 * (j))
#define XB_XSUB(j)  (1280 + 64 * (j))
#define XB_XGEN(j)  (2304 + 64 * (j))
#define XB_TOP      3328
#define XB_TOPGEN   3392
#define XCD_BAR_WORDS 3456
#define XB_SPIN_CAP (1u << 18)

__device__ __forceinline__ unsigned xb_ld(unsigned* p)              { return __hip_atomic_load(p, __ATOMIC_RELAXED, __HIP_MEMORY_SCOPE_AGENT); }
__device__ __forceinline__ unsigned xb_add(unsigned* p, unsigned v) { return __hip_atomic_fetch_add(p, v, __ATOMIC_RELAXED, __HIP_MEMORY_SCOPE_AGENT); }
__device__ __forceinline__ unsigned xb_xcc_id() { return (unsigned)__builtin_amdgcn_s_getreg((3 << 11) | 20) & 0xFu; }
#define XB_SPIN(cond, bar) do { unsigned _sp = 0; while (cond) { __builtin_amdgcn_s_sleep(1); \
    if ((++_sp & 255u) == 0u) { if (xb_ld(&(bar)[XB_TMO])) break; if (_sp > XB_SPIN_CAP) { atomicAdd(&(bar)[XB_TMO], 1u); break; } } } } while (0)

struct XcdBarrier {
    unsigned* bar; unsigned x;
    volatile LAS unsigned* st;
};

__device__ __forceinline__ XcdBarrier xcd_barrier_post(unsigned* bar, volatile LAS unsigned* st) {
    XcdBarrier b; b.bar = bar; b.x = xb_xcc_id(); b.st = st;
    if (threadIdx.x == 0) (void)xb_add(&bar[XB_XCNT(b.x)], 1u);
    return b;
}
__device__ __forceinline__ void xcd_barrier_complete(unsigned* bar, unsigned x, unsigned& nloc, unsigned& nx) {
    const unsigned G = gridDim.x * gridDim.y * gridDim.z;
    unsigned sum, cnt, mine, sp = 0u;
    for (;;) {
        sum = 0u; cnt = 0u; mine = 0u;
#pragma unroll
        for (unsigned j = 0; j < 16; ++j) { const unsigned c = xb_ld(&bar[XB_XCNT(j)]); sum += c; cnt += (c > 0u) ? 1u : 0u; mine = (j == x) ? c : mine; }
        if (sum == G) break;
        __builtin_amdgcn_s_sleep(1);
        if ((++sp & 255u) == 0u) { if (xb_ld(&bar[XB_TMO])) break; if (sp > XB_SPIN_CAP) { atomicAdd(&bar[XB_TMO], 1u); break; } }
    }
    nloc = mine > 0u ? mine : 1u; nx = cnt > 0u ? cnt : 1u;
}

__device__ __forceinline__ void xcd_barrier(const XcdBarrier& b) {
    asm volatile("s_waitcnt vmcnt(0)" ::: "memory");
    __syncthreads();
    if (threadIdx.x == 0) {
        unsigned* bar = b.bar;
        __builtin_amdgcn_s_waitcnt(0);
        unsigned nloc = b.st[0], nx = b.st[1];
        if (nloc == 0u) { xcd_barrier_complete(bar, b.x, nloc, nx); b.st[0] = nloc; b.st[1] = nx; }
        const unsigned old = xb_add(&bar[XB_XSUB(b.x)], 1u);
        const unsigned gen = old / nloc;
        if (old + 1u == (gen + 1u) * nloc) {
            __builtin_amdgcn_fence(__ATOMIC_RELEASE, "agent");
            asm volatile("s_waitcnt vmcnt(0)" ::: "memory");
            const unsigned og = xb_add(&bar[XB_TOP], 1u);
            const unsigned tg = og / nx;
            if (og + 1u == (tg + 1u) * nx) xb_add(&bar[XB_TOPGEN], 1u);
            else XB_SPIN(xb_ld(&bar[XB_TOPGEN]) == tg, bar);
            __builtin_amdgcn_fence(__ATOMIC_ACQUIRE, "agent");
            xb_add(&bar[XB_XGEN(b.x)], 1u);
            asm volatile("s_waitcnt vmcnt(0)" ::: "memory");
        } else {
            XB_SPIN(xb_ld(&bar[XB_XGEN(b.x)]) == gen, bar);
            __builtin_amdgcn_fence(__ATOMIC_ACQUIRE, "agent");
            asm volatile("s_waitcnt vmcnt(0)" ::: "memory");
        }
    }
    __syncthreads();
}


__global__ void __launch_bounds__(512, 2) fwd_megakernel(Args a) {
    extern __shared__ __attribute__((aligned(16))) unsigned char lds_raw[];
    LAS unsigned char* lds = (LAS unsigned char*)lds_raw;
    cg::grid_group grid = cg::this_grid();
    const int panel = blockIdx.x;
    if (threadIdx.x < 2) ((LAS unsigned*)(lds + LDS_XB))[threadIdx.x] = 0u;
    __syncthreads();
    const XcdBarrier xbar = xcd_barrier_post((unsigned*)kargs()->ws, (volatile LAS unsigned*)(lds + LDS_XB));
#define PHASE_PTRS() CArgs* ka = kargs(); unsigned char* ws = ka->ws; unsigned char* PB = ws + WS_PANEL + (size_t)panel * PANEL_BYTES; \
        bf16_t* HBp = (bf16_t*)(ws + WS_HB) + (size_t)panel * 256 * DM; float* Hp = ka->out + (size_t)panel * 256 * DM; (void)PB; (void)HBp; (void)Hp

#ifndef NO_PRO
    prologue(*kargs(), lds, panel, (int)gridDim.x);
#endif
    grid.sync();

#ifdef ONE_LAYER
    for (int l = 0; l < 1; ++l) {
#else
    for (int l = 0; l < NLAYER; ++l) {
#endif
        gz_phase(*kargs(), l, panel);
        {
            PHASE_PTRS();
            pg8::Gemm g{HBp, (const bf16_t*)(ws + WS_WIN) + (size_t)l * DINP * DM, DM}; pg8::PanelOrder S{NZ_MAIN / 256};
            pg8::EpiBf16<0> E{(bf16_t*)(PB + P_Z), DINP};
#ifndef NO_G1
            pg8::gemm_phase(lds, g, S, E);
#if REP_GEMM
            block_fence(); pg8::gemm_phase(lds, g, S, E);
#endif
#endif
        }
        xcd_barrier(xbar);
#ifndef NO_LRU
        lru_pass<1>(*kargs(), l, panel);
#endif
#ifndef NO_S5
        s5_pass<1>(*kargs(), lds, l, panel);
#endif
        __syncthreads();
#ifndef NO_GLA
        gla_pass<1>(*kargs(), lds, l, panel);
#endif
#if REP_MIX
        __syncthreads(); lru_pass<1>(*kargs(), l, panel); s5_pass<1>(*kargs(), lds, l, panel); __syncthreads(); gla_pass<1>(*kargs(), lds, l, panel);
#endif
#if REP_GLA
        __syncthreads(); gla_pass<1>(*kargs(), lds, l, panel);
#endif
#if REP_S5
        __syncthreads(); s5_pass<1>(*kargs(), lds, l, panel); __syncthreads();
#endif
        xcd_barrier(xbar);
#ifndef NO_SCAN
        scan_phase(*kargs(), l);
#endif
        xcd_barrier(xbar);
#ifndef NO_LRU
        lru_apply(*kargs(), l, panel);
#endif
#ifndef NO_S5
        s5_pass<2>(*kargs(), lds, l, panel);
#endif
        __syncthreads();
#ifndef NO_GLA
        gla_pass<2>(*kargs(), lds, l, panel);
#endif
#if REP_MIX
        __syncthreads(); lru_apply(*kargs(), l, panel); s5_pass<2>(*kargs(), lds, l, panel); __syncthreads(); gla_pass<2>(*kargs(), lds, l, panel);
#endif
#if REP_GLA
        __syncthreads(); gla_pass<2>(*kargs(), lds, l, panel);
#endif
#if REP_S5
        __syncthreads(); s5_pass<2>(*kargs(), lds, l, panel); __syncthreads();
#endif
        block_fence();
        {
            PHASE_PTRS();
            pg8::Gemm g{(const bf16_t*)(PB + P_YS5), (const bf16_t*)(ws + WS_WGLU) + (size_t)l * 256 * 256, 256}; pg8::PanelOrder S{1};
            pg8::EpiGlu E{(const bf16_t*)(PB + P_YS5), 256, (bf16_t*)(PB + P_MIX), DM};
#ifndef NO_G2
            pg8::gemm_phase(lds, g, S, E);
#endif
        }
        block_fence();
        {
            PHASE_PTRS();
            pg8::Gemm g{(const bf16_t*)(PB + P_MIX), (const bf16_t*)(ws + WS_WOUT) + (size_t)l * DM * DM, DM}; pg8::PanelOrder S{DM / 256};
            pg8::EpiRes E{HBp, DM, ALPHA};
#ifndef NO_G3
            pg8::gemm_phase(lds, g, S, E);
#endif
        }
        block_fence();
        { PHASE_PTRS(); ln_panel_b(HBp, nullptr, ka->in[24] + l * DM, ka->in[25] + l * DM); }
        block_fence();
        {
            PHASE_PTRS();
            pg8::Gemm g{HBp, (const bf16_t*)(ws + WS_W1) + (size_t)l * DFF * DM, DM}; pg8::PanelOrder S{DFF / 256};
            pg8::EpiBf16<1> E{(bf16_t*)(PB + P_HID), DFF};
#ifndef NO_G4
            pg8::gemm_phase(lds, g, S, E);
#if REP_GEMM
            block_fence(); pg8::gemm_phase(lds, g, S, E);
#endif
#endif
        }
        block_fence();
        {
            PHASE_PTRS();
            pg8::Gemm g{(const bf16_t*)(PB + P_HID), (const bf16_t*)(ws + WS_W2) + (size_t)l * DM * DFF, DFF}; pg8::PanelOrder S{DM / 256};
            pg8::EpiRes E{HBp, DM, ALPHA};
#ifndef NO_G5
            pg8::gemm_phase(lds, g, S, E);
#endif
        }
        block_fence();
        { PHASE_PTRS(); ln_panel_b(HBp, (l + 1 == NLAYER) ? Hp : nullptr, ka->in[28] + l * DM, ka->in[29] + l * DM); }
        block_fence();
    }
}

extern "C" void kernel_launch(void* const* d_in, const int* in_sizes, int n_in, void* d_out, int out_size, void* d_ws, size_t ws_size, hipStream_t stream) {
    static int ready = 0;
    if (ready == 0) {
        if (n_in != 30 || in_sizes[0] != M_TOK * DM || out_size != M_TOK * DM || ws_size < WS_END) {
            fprintf(stderr, "kernel_launch: unexpected shapes (n_in %d, in0 %d, out %d, ws %zu)\n", n_in, n_in > 0 ? in_sizes[0] : -1, out_size, ws_size); ready = -1; return; }
        if (hipFuncSetAttribute((const void*)fwd_megakernel, hipFuncAttributeMaxDynamicSharedMemorySize, LDS_BYTES) != hipSuccess) { fprintf(stderr, "kernel_launch: hipFuncSetAttribute failed\n"); ready = -1; return; }
        int dev = 0, cus = 0, per_cu = 0;
        hipGetDevice(&dev); hipDeviceGetAttribute(&cus, hipDeviceAttributeMultiprocessorCount, dev);
        hipOccupancyMaxActiveBlocksPerMultiprocessor(&per_cu, (const void*)fwd_megakernel, 512, LDS_BYTES);
        if (cus * per_cu < NPANEL) fprintf(stderr, "kernel_launch: note: %d CUs x %d blocks/CU < %d workgroups\n", cus, per_cu, NPANEL);
        (void)hipGetLastError();
        ready = 1;
    }
    if (ready < 0) return;
    if (hipMemsetAsync(d_ws, 0, 16384, stream) != hipSuccess) { fprintf(stderr, "kernel_launch: hipMemsetAsync failed\n"); return; }
    Args a{};
    for (int i = 0; i < 30; ++i) a.in[i] = (const float*)d_in[i];
    a.out = (float*)d_out; a.ws = (unsigned char*)d_ws;
    void* args[] = {&a};
    hipError_t e = hipLaunchCooperativeKernel((const void*)fwd_megakernel, dim3(NPANEL), dim3(512), args, LDS_BYTES, stream);
    if (e != hipSuccess) fprintf(stderr, "kernel_launch: cooperative launch failed: %s\n", hipGetErrorString(e));
}
```
